# Optimizing an MI355X kernel written in HIP

```python
import math
import jax, jax.numpy as jnp
from jax import lax
import numpy as np

D_MODEL = 1024
BATCH = 4
SEQ = 8192
DEPTH = 1
DEC_BATCH = 32
DEC_SEQ = 64
PAST_LEN = 1024

CHUNK = 64
RET_HEADS = 8
RET_DK = 64
RET_DV = 64
RET_QK = RET_HEADS * RET_DK
RET_WIDTH = RET_HEADS * RET_DV
RET_THETA = 10000.0
DIFF_HEADS = 4
DIFF_DK = 64
DIFF_DV = 2 * DIFF_DK
DIFF_QK = DIFF_HEADS * 2 * DIFF_DK
DIFF_WIDTH = DIFF_HEADS * DIFF_DV
ROPE_THETA = 500000.0
ROPE_DIM = DIFF_DK // 4
MIX_WIDTH = RET_WIDTH + DIFF_WIDTH
Q_BLOCK = 128
EPS = 1e-6
NEG_BIG = -1e30
IN_SIZES = (RET_QK, RET_QK, RET_WIDTH, RET_WIDTH, DIFF_QK, DIFF_QK, DIFF_WIDTH, DIFF_WIDTH)
IN_SPLITS = tuple(sum(IN_SIZES[:i + 1]) for i in range(len(IN_SIZES) - 1))
IN_WIDTH = sum(IN_SIZES)

kernel_name = 'hybrid_retention_diffattn_stream_step'


def rmsnorm(x, g):
    xf = x.astype(jnp.float32)
    y = xf * lax.rsqrt(jnp.mean(xf * xf, axis=-1, keepdims=True) + EPS)
    return (y * g.astype(jnp.float32)).astype(x.dtype)


def rotary_tables(pos, dim, theta):
    inv_freq = 1.0 / (theta ** (jnp.arange(0, dim, 2, dtype=jnp.float32) / dim))
    ang = pos[:, None] * inv_freq[None, :]
    return jnp.cos(ang), jnp.sin(ang)


def rotate_half(x, cos, sin):
    half = x.shape[-1] // 2
    x1, x2 = x[..., :half], x[..., half:]
    cos = cos.astype(x.dtype)
    sin = sin.astype(x.dtype)
    return jnp.concatenate([x1 * cos - x2 * sin, x2 * cos + x1 * sin], axis=-1)


def retention_log_decay():
    return jnp.log1p(-jnp.exp2(-5.0 - jnp.arange(RET_HEADS, dtype=jnp.float32)))


def branch_inputs(x, norm_g, w_in, pos):
    b, l, _ = x.shape
    h = rmsnorm(x, norm_g)
    z = jnp.einsum('bld,de->ble', h, w_in)
    rq, rk, rv, rg, dq, dk, dv, dg = jnp.split(z, IN_SPLITS, axis=-1)
    rcos, rsin = rotary_tables(pos, RET_DK, RET_THETA)
    rcos, rsin = rcos[None, :, None, :], rsin[None, :, None, :]
    rq = rotate_half(rq.reshape(b, l, RET_HEADS, RET_DK), rcos, rsin)
    rk = rotate_half(rk.reshape(b, l, RET_HEADS, RET_DK), rcos, rsin) * (RET_DK ** -0.5)
    rv = rv.reshape(b, l, RET_HEADS, RET_DV)
    dcos, dsin = rotary_tables(pos, ROPE_DIM, ROPE_THETA)
    dcos, dsin = dcos[None, :, None, None, :], dsin[None, :, None, None, :]

    def partial_rope(t):
        t = t.reshape(b, l, DIFF_HEADS, 2, DIFF_DK)
        return jnp.concatenate([rotate_half(t[..., :ROPE_DIM], dcos, dsin), t[..., ROPE_DIM:]], axis=-1)

    dq = partial_rope(dq)
    dk = partial_rope(dk)
    dv = dv.reshape(b, l, DIFF_HEADS, DIFF_DV)
    return rq, rk, rv, rg, dq, dk, dv, dg


def retention_block(q, k, v, s, log_g):
    q = q.astype(jnp.float32)
    k = k.astype(jnp.float32)
    v = v.astype(jnp.float32)
    s = s.astype(jnp.float32)
    l = q.shape[1]
    idx = jnp.arange(l, dtype=jnp.float32)
    rel = idx[:, None] - idx[None, :]
    decay = jnp.where((rel >= 0)[None], jnp.exp(log_g[:, None, None] * jnp.maximum(rel, 0.0)[None]), 0.0)
    scores = jnp.einsum('bqhd,bkhd->bhqk', q, k) * decay[None]
    inner = jnp.einsum('bhqk,bkhe->bqhe', scores, v)
    q_decay = jnp.exp(log_g[None, :] * (idx[:, None] + 1.0))
    cross = jnp.einsum('bqhd,bhde->bqhe', q, s) * q_decay[None, :, :, None]
    k_decay = jnp.exp(log_g[None, :] * (l - 1.0 - idx[:, None]))
    s_new = (jnp.exp(log_g * l)[None, :, None, None] * s
             + jnp.einsum('bkhd,bkhe->bhde', k * k_decay[None, :, :, None], v))
    return inner + cross, s_new


def retention_prompt(q, k, v, log_g):
    b, l = q.shape[0], q.shape[1]
    nc = l // CHUNK

    def to_blocks(t):
        return t.reshape(b, nc, CHUNK, RET_HEADS, t.shape[-1]).swapaxes(0, 1)

    s0 = jnp.zeros((b, RET_HEADS, RET_DK, RET_DV), jnp.float32)

    def step(s, blk):
        qc, kc, vc = blk
        o, s = retention_block(qc, kc, vc, s, log_g)
        return s, o

    s, o = lax.scan(step, s0, (to_blocks(q), to_blocks(k), to_blocks(v)))
    return o.swapaxes(0, 1).reshape(b, l, RET_HEADS, RET_DV), s


def diff_attend(q, k, v, lam, mask):
    logits = jnp.einsum('bqhcd,bkhcd->bhcqk', q, k, preferred_element_type=jnp.float32) * (DIFF_DK ** -0.5)
    if mask is not None:
        logits = jnp.where(mask, logits, NEG_BIG)
    p = jax.nn.softmax(logits, axis=-1)
    w = p[:, :, 0] - lam * p[:, :, 1]
    o = jnp.einsum('bhqk,bkhe->bqhe', w, v.astype(jnp.float32))
    return o.astype(v.dtype)


def diff_attention_prompt(q, k, v, lam):
    b, l = q.shape[0], q.shape[1]
    nb = l // Q_BLOCK
    q_blocks = q.reshape(b, nb, Q_BLOCK, DIFF_HEADS, 2, DIFF_DK).swapaxes(0, 1)
    key_chunk = jnp.arange(l) // CHUNK

    def one_block(args):
        q_blk, blk = args
        q_chunk = (blk * Q_BLOCK + jnp.arange(Q_BLOCK)) // CHUNK
        mask = key_chunk[None, :] <= q_chunk[:, None]
        return diff_attend(q_blk, k, v, lam, mask)

    o = lax.map(one_block, (q_blocks, jnp.arange(nb)))
    return o.swapaxes(0, 1).reshape(b, l, DIFF_HEADS, DIFF_DV)


def merge_branches(ret_o, ret_g, diff_o, diff_g, ret_norm_g, diff_norm_g, lambda_init, w_out):
    b, l = ret_o.shape[0], ret_o.shape[1]
    ret = rmsnorm(ret_o, ret_norm_g.reshape(RET_HEADS, RET_DV)).reshape(b, l, RET_WIDTH)
    dif = (rmsnorm(diff_o, diff_norm_g) * (1.0 - lambda_init)).reshape(b, l, DIFF_WIDTH)
    mixed = jnp.concatenate([jax.nn.silu(ret_g) * ret, jax.nn.silu(diff_g) * dif], axis=-1)
    return jnp.einsum('ble,ed->bld', mixed, w_out)


def setup_inputs(seed: int = 0) -> dict:
    key = jax.random.key(seed)
    ks = jax.random.split(key, 15)
    f32 = jnp.float32
    nrm = jax.random.normal
    return {
        'x_prompt': nrm(ks[0], (BATCH, SEQ, D_MODEL), f32),
        'x_sample': nrm(ks[1], (DEC_BATCH, DEC_SEQ, D_MODEL), f32),
        'cache_k': nrm(ks[2], (DEPTH, DEC_BATCH, PAST_LEN, DIFF_HEADS, DIFF_DV), f32),
        'cache_v': nrm(ks[3], (DEPTH, DEC_BATCH, PAST_LEN, DIFF_HEADS, DIFF_DV), f32),
        'state_ret': nrm(ks[4], (DEPTH, DEC_BATCH, RET_HEADS, RET_DK, RET_DV), f32),
        'norm_g': 1.0 + 0.02 * nrm(ks[5], (DEPTH, D_MODEL), f32),
        'w_in': nrm(ks[6], (DEPTH, D_MODEL, IN_WIDTH), f32) * (D_MODEL ** -0.5),
        'w_out': nrm(ks[7], (DEPTH, MIX_WIDTH, D_MODEL), f32) * (MIX_WIDTH ** -0.5),
        'ret_norm_g': 1.0 + 0.02 * nrm(ks[8], (DEPTH, RET_WIDTH), f32),
        'diff_norm_g': 1.0 + 0.02 * nrm(ks[9], (DEPTH, DIFF_DV), f32),
        'lam_q1': 0.1 * nrm(ks[10], (DEPTH, DIFF_DK), f32),
        'lam_k1': 0.1 * nrm(ks[11], (DEPTH, DIFF_DK), f32),
        'lam_q2': 0.1 * nrm(ks[12], (DEPTH, DIFF_DK), f32),
        'lam_k2': 0.1 * nrm(ks[13], (DEPTH, DIFF_DK), f32),
        'final_norm_g': 1.0 + 0.02 * nrm(ks[14], (D_MODEL,), f32),
    }


def reference(x_prompt, x_sample, cache_k, cache_v, state_ret, norm_g, w_in, w_out, ret_norm_g,
              diff_norm_g, lam_q1, lam_k1, lam_q2, lam_k2, final_norm_g):
    past = cache_k.shape[2]
    pos_p = jnp.arange(x_prompt.shape[1], dtype=jnp.float32)
    pos_s = past + jnp.arange(x_sample.shape[1], dtype=jnp.float32)
    log_g = retention_log_decay()
    xp, xs = x_prompt, x_sample
    bp, lp = xp.shape[0], xp.shape[1]
    bs = xs.shape[0]
    ret_p, ret_s, kp, vp, ks_new, vs_new = [], [], [], [], [], []
    for layer in range(DEPTH):
        lambda_init = 0.8 - 0.6 * math.exp(-0.3 * layer)
        lam = (jnp.exp(jnp.sum(lam_q1[layer].astype(jnp.float32) * lam_k1[layer].astype(jnp.float32)))
               - jnp.exp(jnp.sum(lam_q2[layer].astype(jnp.float32) * lam_k2[layer].astype(jnp.float32)))
               + lambda_init)
        rq, rk, rv, rg, dq, dk, dv, dg = branch_inputs(xp, norm_g[layer], w_in[layer], pos_p)
        ro, rs = retention_prompt(rq, rk, rv, log_g)
        do = diff_attention_prompt(dq, dk, dv, lam)
        xp = xp + merge_branches(ro.astype(xp.dtype), rg, do, dg, ret_norm_g[layer], diff_norm_g[layer],
                                 lambda_init, w_out[layer])
        ret_p.append(rs)
        kp.append(dk.reshape(bp, lp, DIFF_HEADS, DIFF_DV))
        vp.append(dv)
        srq, srk, srv, srg, sdq, sdk, sdv, sdg = branch_inputs(xs, norm_g[layer], w_in[layer], pos_s)
        sro, sst = retention_block(srq, srk, srv, state_ret[layer], log_g)
        k_all = jnp.concatenate(
            [cache_k[layer].reshape(bs, past, DIFF_HEADS, 2, DIFF_DK).astype(sdk.dtype), sdk], axis=1)
        v_all = jnp.concatenate([cache_v[layer].astype(sdv.dtype), sdv], axis=1)
        sdo = diff_attend(sdq, k_all, v_all, lam, None)
        xs = xs + merge_branches(sro.astype(xs.dtype), srg, sdo, sdg, ret_norm_g[layer], diff_norm_g[layer],
                                 lambda_init, w_out[layer])
        ret_s.append(sst)
        ks_new.append(sdk.reshape(bs, xs.shape[1], DIFF_HEADS, DIFF_DV))
        vs_new.append(sdv)
    y_prompt = rmsnorm(xp, final_norm_g)
    y_sample = rmsnorm(xs, final_norm_g)
    return (y_prompt, y_sample, jnp.stack(ret_p), jnp.stack(ret_s), jnp.stack(kp), jnp.stack(vp),
            jnp.stack(ks_new), jnp.stack(vs_new))
```

```cpp
#include <hip/hip_runtime.h>
#include <hip/hip_cooperative_groups.h>
#include <cstdio>
#include <cstdint>
namespace cg = cooperative_groups;

#ifndef REP1
#define REP1 1
#endif
#ifndef REP3
#define REP3 1
#endif
#ifndef REP5
#define REP5 1
#endif
#ifndef REP0
#define REP0 1
#endif
#ifndef MULTI_LAUNCH
#define MULTI_LAUNCH 0
#endif

typedef unsigned short u16;
typedef short bf16x8 __attribute__((ext_vector_type(8)));
typedef float f32x4 __attribute__((ext_vector_type(4)));
typedef float f32x2 __attribute__((ext_vector_type(2)));
typedef float f32x16 __attribute__((ext_vector_type(16)));
typedef unsigned u32x4 __attribute__((ext_vector_type(4)));
typedef unsigned u32x2 __attribute__((ext_vector_type(2)));
typedef __bf16 bf16x2_t __attribute__((ext_vector_type(2)));

#define DI __device__ __forceinline__
#define MFMA32(a, b, c) __builtin_amdgcn_mfma_f32_32x32x16_bf16((a), (b), (c), 0, 0, 0)

constexpr int D = 1024, TP = 32768, TS = 2048, T = TP + TS, PAST = 1024, SKL = 1088;
constexpr int NTHREADS = 256;
constexpr int LDS_BYTES = 73728 + 64;
constexpr float EPS = 1e-6f;
constexpr float QSCALE = 0.125f * 1.4426950408889634f;
constexpr size_t O_Y = 0, O_SP = 35651584, O_SS = 35782656, O_KP = 36831232, O_VP = 53608448, O_KS = 70385664, O_VS = 71434240;
constexpr size_t TR_S_OFF = 16777216;
constexpr int NITEMS = 32 + 2048 + 128 + 256;

struct Params {
    const float *x_p, *x_s, *cache_k, *cache_v, *state_ret, *norm_g, *w_in, *w_out, *ret_norm_g, *diff_norm_g, *lam_q1, *lam_k1, *lam_q2, *lam_k2, *final_g;
    float* out;
    u16 *H, *WtIn, *WtOut, *RQ, *RK, *RKtd, *RVt, *RG, *DQ, *DKp, *SK, *DVtp, *SVt, *DG, *MIX, *SPREV;
    float *cosR, *sinR, *cosD, *sinD, *misc, *rowss;
    unsigned* ctr; unsigned* bar; unsigned* done;
    int never; int pad_;
};

DI unsigned pk2(float lo, float hi) { f32x2 v = {lo, hi}; bf16x2_t b = __builtin_convertvector(v, bf16x2_t); return __builtin_bit_cast(unsigned, b); }
DI u16 f2bf(float x) { return (u16)(pk2(x, 0.f) & 0xffffu); }
DI float bf2f(unsigned v) { return __uint_as_float(v << 16); }
DI int crow(int i, int h) { return (i & 3) + 8 * (i >> 2) + 4 * h; }
DI float silu(float v) { return v / (1.f + __expf(-v)); }
DI float log2_gamma(int hd) {
    const float x = exp2f(-5.f - (float)hd);
    float s = x * (1.f + x * (0.5f + x * (1.f / 3.f + x * (0.25f + x * (0.2f + x * (1.f / 6.f))))));
    return -s * 1.4426950408889634f;
}
template <int S> DI bf16x8 pack8(const f32x16& x) {
    u32x4 p;
    p.x = pk2(x[8 * S + 0], x[8 * S + 1]); p.y = pk2(x[8 * S + 2], x[8 * S + 3]);
    p.z = pk2(x[8 * S + 4], x[8 * S + 5]); p.w = pk2(x[8 * S + 6], x[8 * S + 7]);
    return __builtin_bit_cast(bf16x8, p);
}
DI float xhalf_max(float v) { auto r = __builtin_amdgcn_permlane32_swap(__float_as_uint(v), __float_as_uint(v), false, false); return fmaxf(__uint_as_float(r[0]), __uint_as_float(r[1])); }
DI float xhalf_sum(float v) { auto r = __builtin_amdgcn_permlane32_swap(__float_as_uint(v), __float_as_uint(v), false, false); return __uint_as_float(r[0]) + __uint_as_float(r[1]); }
DI f32x16 zero16() { f32x16 z; for (int i = 0; i < 16; ++i) z[i] = 0.f; return z; }


#define XB_TMO      128
#define XB_XCNT(j)  (256  + 64 * (j))
#define XB_XSUB(j)  (1280 + 64 * (j))
#define XB_XGEN(j)  (2304 + 64 * (j))
#define XB_TOP      3328
#define XB_TOPGEN   3392
#define XCD_BAR_WORDS 3456
#define XB_SPIN_CAP (1u << 20)
#define LAS __attribute__((address_space(3)))
DI unsigned xb_ld(unsigned* p)              { return __hip_atomic_load(p, __ATOMIC_RELAXED, __HIP_MEMORY_SCOPE_AGENT); }
DI unsigned xb_add(unsigned* p, unsigned v) { return __hip_atomic_fetch_add(p, v, __ATOMIC_RELAXED, __HIP_MEMORY_SCOPE_AGENT); }
DI unsigned xb_xcc_id() { return (unsigned)__builtin_amdgcn_s_getreg((3 << 11) | 20) & 0xFu; }
#define XB_SPIN(cond, bar) do { unsigned _sp = 0; while (cond) { __builtin_amdgcn_s_sleep(1); \
    if ((++_sp & 255u) == 0u) { if (xb_ld(&(bar)[XB_TMO])) break; if (_sp > XB_SPIN_CAP) { atomicAdd(&(bar)[XB_TMO], 1u); break; } } } } while (0)
struct XcdBarrier { unsigned* bar; unsigned x; volatile LAS unsigned* st; };
DI XcdBarrier xcd_barrier_post(unsigned* bar, volatile LAS unsigned* st) {
    XcdBarrier b; b.bar = bar; b.x = xb_xcc_id(); b.st = st;
    if (threadIdx.x == 0) (void)xb_add(&bar[XB_XCNT(b.x)], 1u);
    return b;
}
DI void xcd_barrier_complete(unsigned* bar, unsigned x, unsigned& nloc, unsigned& nx) {
    const unsigned G = gridDim.x * gridDim.y * gridDim.z;
    unsigned sum, cnt, mine, sp = 0u;
    for (;;) {
        sum = 0u; cnt = 0u; mine = 0u;
#pragma unroll
        for (unsigned j = 0; j < 16; ++j) { const unsigned c = xb_ld(&bar[XB_XCNT(j)]); sum += c; cnt += (c > 0u) ? 1u : 0u; mine = (j == x) ? c : mine; }
        if (sum == G) break;
        __builtin_amdgcn_s_sleep(1);
        if ((++sp & 255u) == 0u) { if (xb_ld(&bar[XB_TMO])) break; if (sp > XB_SPIN_CAP) { atomicAdd(&bar[XB_TMO], 1u); break; } }
    }
    nloc = mine > 0u ? mine : 1u; nx = cnt > 0u ? cnt : 1u;
}
DI void xcd_barrier(const XcdBarrier& b) {
    asm volatile("s_waitcnt vmcnt(0)" ::: "memory");
    __syncthreads();
    if (threadIdx.x == 0) {
        unsigned* bar = b.bar;
        __builtin_amdgcn_s_waitcnt(0);
        unsigned nloc = b.st[0], nx = b.st[1];
        if (nloc == 0u) { xcd_barrier_complete(bar, b.x, nloc, nx); b.st[0] = nloc; b.st[1] = nx; }
        const unsigned old = xb_add(&bar[XB_XSUB(b.x)], 1u);
        const unsigned gen = old / nloc;
        if (old + 1u == (gen + 1u) * nloc) {
            __builtin_amdgcn_fence(__ATOMIC_RELEASE, "agent");
            asm volatile("s_waitcnt vmcnt(0)" ::: "memory");
            const unsigned og = xb_add(&bar[XB_TOP], 1u);
            const unsigned tg = og / nx;
            if (og + 1u == (tg + 1u) * nx) xb_add(&bar[XB_TOPGEN], 1u);
            else XB_SPIN(xb_ld(&bar[XB_TOPGEN]) == tg, bar);
            __builtin_amdgcn_fence(__ATOMIC_ACQUIRE, "agent");
            xb_add(&bar[XB_XGEN(b.x)], 1u);
            asm volatile("s_waitcnt vmcnt(0)" ::: "memory");
        } else {
            XB_SPIN(xb_ld(&bar[XB_XGEN(b.x)]) == gen, bar);
            __builtin_amdgcn_fence(__ATOMIC_ACQUIRE, "agent");
            asm volatile("s_waitcnt vmcnt(0)" ::: "memory");
        }
    }
    __syncthreads();
}

struct TJob { const float* src; size_t ss; u16* dst; size_t ds; bool perm; };
DI TJob tjob(const Params& p, int t) {
    TJob j;
    if (t < 1024) { const int kt = t >> 6, nt = t & 63;
        j.src = p.w_in + (size_t)kt * 64 * 4096 + nt * 64; j.ss = 4096; j.dst = p.WtIn + (size_t)nt * 64 * 1024 + kt * 64; j.ds = 1024; j.perm = false;
    } else if (t < 1280) { const int q = t - 1024, kt = q >> 4, nt = q & 15;
        j.src = p.w_out + (size_t)kt * 64 * 1024 + nt * 64; j.ss = 1024; j.dst = p.WtOut + (size_t)nt * 64 * 1024 + kt * 64; j.ds = 1024; j.perm = false;
    } else { const int q = t - 1280, sbh = q >> 5, keyt = (q >> 1) & 15, dvt = q & 1, sb = sbh >> 2, hh = sbh & 3;
        j.src = p.cache_v + ((size_t)sb * 1024 + keyt * 64) * 512 + hh * 128 + dvt * 64; j.ss = 512; j.dst = p.SVt + ((size_t)sbh * 17 + keyt) * 8192 + dvt * 64 * 64; j.ds = 64; j.perm = true;
    }
    return j;
}
DI void tr_load(const TJob& j, f32x4 (&v)[4], int tid) {
#pragma unroll
    for (int i = 0; i < 4; ++i) v[i] = __builtin_nontemporal_load((const f32x4*)(j.src + (size_t)((tid >> 4) + 16 * i) * j.ss + (tid & 15) * 4));
}
DI void tr_put(const f32x4 (&v)[4], float* tile, int tid) {
#pragma unroll
    for (int i = 0; i < 4; ++i) { const int r = (tid >> 4) + 16 * i, c4 = (tid & 15) * 4;
        tile[(c4 + 0) * 65 + r] = v[i].x; tile[(c4 + 1) * 65 + r] = v[i].y; tile[(c4 + 2) * 65 + r] = v[i].z; tile[(c4 + 3) * 65 + r] = v[i].w; }
}
DI void tr_store(const TJob& j, const float* tile, int tid) {
#pragma unroll
    for (int i = 0; i < 2; ++i) {
        const int id = tid + 256 * i, c = id >> 3, p0 = (id & 7) * 8;
        float e[8];
#pragma unroll
        for (int jj = 0; jj < 8; ++jj) { const int pos = p0 + jj; const int r = j.perm ? ((pos & ~12) | ((pos & 4) << 1) | ((pos & 8) >> 1)) : pos; e[jj] = tile[c * 65 + r]; }
        u32x4 w; w.x = pk2(e[0], e[1]); w.y = pk2(e[2], e[3]); w.z = pk2(e[4], e[5]); w.w = pk2(e[6], e[7]);
        *(u32x4*)(j.dst + (size_t)c * j.ds + p0) = w;
    }
}

__device__ void p0_prep(const Params& p, unsigned char* smem) {
    int tid = threadIdx.x; asm volatile("" : "+v"(tid)); const int lane = tid & 63, wid = tid >> 6, nb = gridDim.x, bid = blockIdx.x;
    if (bid == 0 && tid == 0) {
        float s1 = 0.f, s2 = 0.f;
        for (int i = 0; i < 64; ++i) { s1 += p.lam_q1[i] * p.lam_k1[i]; s2 += p.lam_q2[i] * p.lam_k2[i]; }
        p.misc[0] = expf(s1) - expf(s2) + 0.2f;
        for (int i = 0; i < 288; ++i) p.ctr[i] = 0u;
        for (int i = 0; i < 128; ++i) p.done[i] = 0u;
    }
    for (int i = bid * 256 + tid; i < T; i += nb * 256) p.rowss[i] = 0.f;
    for (int row = (bid * 4 + wid) * 2; row < T; row += nb * 8) {
        f32x4 v[2][4]; float ss[2] = {0.f, 0.f};
#pragma unroll
        for (int q = 0; q < 2; ++q) { const int rw = row + q; const float* src = rw < TP ? p.x_p + (size_t)rw * D : p.x_s + (size_t)(rw - TP) * D;
#pragma unroll
            for (int i = 0; i < 4; ++i) v[q][i] = __builtin_nontemporal_load((const f32x4*)(src + (lane + 64 * i) * 4)); }
        f32x4 g[4];
#pragma unroll
        for (int i = 0; i < 4; ++i) g[i] = *(const f32x4*)(p.norm_g + (lane + 64 * i) * 4);
#pragma unroll
        for (int q = 0; q < 2; ++q) {
#pragma unroll
            for (int i = 0; i < 4; ++i) ss[q] += v[q][i].x * v[q][i].x + v[q][i].y * v[q][i].y + v[q][i].z * v[q][i].z + v[q][i].w * v[q][i].w;
#pragma unroll
            for (int o = 32; o >= 1; o >>= 1) ss[q] += __shfl_xor(ss[q], o);
            const float rstd = rsqrtf(ss[q] * (1.f / 1024.f) + EPS);
#pragma unroll
            for (int i = 0; i < 4; ++i) {
                u32x2 w; w.x = pk2(v[q][i].x * rstd * g[i].x, v[q][i].y * rstd * g[i].y); w.y = pk2(v[q][i].z * rstd * g[i].z, v[q][i].w * rstd * g[i].w);
                *(u32x2*)(p.H + (size_t)(row + q) * D + (lane + 64 * i) * 4) = w;
            }
        }
    }
    float* tile0 = (float*)smem; float* tile1 = tile0 + 64 * 65;
    for (int t = bid; t < 1280; t += 2 * nb) {
        const bool two = t + nb < 1280;
        const TJob j0 = tjob(p, t), j1 = tjob(p, two ? t + nb : t);
        f32x4 v0[4], v1[4];
        tr_load(j0, v0, tid); if (two) tr_load(j1, v1, tid);
        __syncthreads();
        tr_put(v0, tile0, tid); if (two) tr_put(v1, tile1, tid);
        __syncthreads();
        tr_store(j0, tile0, tid); if (two) tr_store(j1, tile1, tid);
    }
    for (int i = bid * 256 + tid; i < 8192 * 40; i += nb * 256) {
        const int pos = i / 40, f = i % 40;
        const float inv = f < 32 ? exp2f(-13.287712379549449f * (float)f * (1.f / 32.f)) : exp2f(-18.931568569324174f * (float)(f - 32) * (1.f / 8.f));
        const float ang = (float)pos * inv;
        const double rev = (double)ang * 0.15915494309189535; const float fr = (float)(rev - rint(rev));
        const float sn = __builtin_amdgcn_sinf(fr), cs = __builtin_amdgcn_cosf(fr);
        if (f < 32) { p.cosR[pos * 32 + f] = cs; p.sinR[pos * 32 + f] = sn; } else { p.cosD[pos * 8 + f - 32] = cs; p.sinD[pos * 8 + f - 32] = sn; }
    }
}

DI void stage_store(float* stg, const float (&v0)[16], const float (&v1)[16], u16* base, size_t ld, int lane, bool nt = true) {
    const int r = lane & 31, h = lane >> 5;
#pragma unroll
    for (int i = 0; i < 16; ++i) { stg[crow(i, h) * 68 + r] = v0[i]; stg[crow(i, h) * 68 + 32 + r] = v1[i]; }
    __builtin_amdgcn_wave_barrier();
#pragma unroll
    for (int j = 0; j < 4; ++j) {
        const int row = (lane >> 3) + 8 * j, ch = lane & 7;
        const f32x4 x = *(const f32x4*)(stg + row * 68 + ch * 8), y = *(const f32x4*)(stg + row * 68 + ch * 8 + 4);
        u32x4 w; w.x = pk2(x.x, x.y); w.y = pk2(x.z, x.w); w.z = pk2(y.x, y.y); w.w = pk2(y.z, y.w);
        if (nt) __builtin_nontemporal_store(w, (u32x4*)(base + (size_t)row * ld + ch * 8));
        else *(u32x4*)(base + (size_t)row * ld + ch * 8) = w;
    }
    __builtin_amdgcn_wave_barrier();
}
DI void store_tr(u16* tb, const float (&v0)[16], const float (&v1)[16], int r, int h, bool nt = true) {
#pragma unroll
    for (int G = 0; G < 2; ++G) {
        u32x4 w0, w1;
        w0.x = pk2(v0[8 * G + 0], v0[8 * G + 1]); w0.y = pk2(v0[8 * G + 2], v0[8 * G + 3]); w0.z = pk2(v0[8 * G + 4], v0[8 * G + 5]); w0.w = pk2(v0[8 * G + 6], v0[8 * G + 7]);
        w1.x = pk2(v1[8 * G + 0], v1[8 * G + 1]); w1.y = pk2(v1[8 * G + 2], v1[8 * G + 3]); w1.z = pk2(v1[8 * G + 4], v1[8 * G + 5]); w1.w = pk2(v1[8 * G + 6], v1[8 * G + 7]);
        if (nt) { __builtin_nontemporal_store(w0, (u32x4*)(tb + (size_t)r * 64 + 16 * G + 8 * h)); __builtin_nontemporal_store(w1, (u32x4*)(tb + (size_t)(32 + r) * 64 + 16 * G + 8 * h)); }
        else { *(u32x4*)(tb + (size_t)r * 64 + 16 * G + 8 * h) = w0; *(u32x4*)(tb + (size_t)(32 + r) * 64 + 16 * G + 8 * h) = w1; }
    }
}
template <int MI> DI void p1_epilogue(const Params& p, const f32x16 (&acc)[MI][2], int mt, int nt, int wm, int wn, int lane, float* stg) {
    const int r = lane & 31, h = lane >> 5;
    const int seg = nt >> 2;
    const int cseg0 = (nt & 3) * 128 + wn * 64;
#pragma unroll
    for (int mi = 0; mi < MI; ++mi) {
        const int tok0 = mt * (64 * MI) + wm * (32 * MI) + mi * 32;
        const bool samp = tok0 >= TP;
        int bseq, t0;
        if (!samp) { bseq = tok0 >> 13; t0 = tok0 & 8191; } else { const int st = tok0 - TP; bseq = st >> 6; t0 = st & 63; }
        const int pos0 = samp ? PAST + t0 : t0;
        float v0[16], v1[16];
        if (seg == 0 || seg == 1) {
            const int head = cseg0 >> 6;
            const float sc = seg == 0 ? 1.f : 0.125f;
#pragma unroll
            for (int i = 0; i < 16; ++i) {
                const int pos = pos0 + crow(i, h);
                const float c = p.cosR[pos * 32 + r], s = p.sinR[pos * 32 + r];
                const float a0 = acc[mi][0][i], a1 = acc[mi][1][i];
                v0[i] = (a0 * c - a1 * s) * sc; v1[i] = (a1 * c + a0 * s) * sc;
            }
            stage_store(stg, v0, v1, (seg == 0 ? p.RQ : p.RK) + (size_t)tok0 * 512 + cseg0, 512, lane);
            if (seg == 1) {
                const float lg = log2_gamma(head);
                u16* tb = (samp ? p.RKtd + TR_S_OFF + (size_t)(bseq * 8 + head) * 4096 : p.RKtd + ((size_t)(bseq * 8 + head) * 128 + (t0 >> 6)) * 4096) + (t0 & 63);
#pragma unroll
                for (int i = 0; i < 16; ++i) { const float dc = __builtin_amdgcn_exp2f(lg * (float)(63 - ((t0 + crow(i, h)) & 63))); v0[i] *= dc; v1[i] *= dc; }
                store_tr(tb, v0, v1, r, h);
            }
        } else if (seg == 2) {
            const int head = cseg0 >> 6;
            u16* tb = (samp ? p.RVt + TR_S_OFF + (size_t)(bseq * 8 + head) * 4096 : p.RVt + ((size_t)(bseq * 8 + head) * 128 + (t0 >> 6)) * 4096) + (t0 & 63);
#pragma unroll
            for (int i = 0; i < 16; ++i) { v0[i] = acc[mi][0][i]; v1[i] = acc[mi][1][i]; }
            store_tr(tb, v0, v1, r, h);
        } else if (seg == 3 || seg == 7) {
#pragma unroll
            for (int i = 0; i < 16; ++i) { v0[i] = silu(acc[mi][0][i]); v1[i] = silu(acc[mi][1][i]); }
            stage_store(stg, v0, v1, (seg == 3 ? p.RG : p.DG) + (size_t)tok0 * 512 + cseg0, 512, lane);
        } else if (seg == 4 || seg == 5) {
#pragma unroll
            for (int i = 0; i < 16; ++i) {
                const int pos = pos0 + crow(i, h);
                const float v = acc[mi][0][i], pr = __shfl_xor(v, 8);
                const float c = p.cosD[pos * 8 + (r & 7)], s = p.sinD[pos * 8 + (r & 7)];
                v0[i] = r < 8 ? v * c - pr * s : (r < 16 ? v * c + pr * s : v); v1[i] = acc[mi][1][i];
            }
            if (seg == 4) {
#pragma unroll
                for (int i = 0; i < 16; ++i) { v0[i] *= QSCALE; v1[i] *= QSCALE; }
                stage_store(stg, v0, v1, p.DQ + (size_t)tok0 * 512 + cseg0, 512, lane);
            } else {
                float* ko = (samp ? p.out + O_KS + (size_t)(tok0 - TP) * 512 : p.out + O_KP + (size_t)tok0 * 512) + cseg0 + r;
                const int head4 = cseg0 >> 7, colh = cseg0 & 127;
                u16* kb = (samp ? p.SK + ((size_t)(bseq * 4 + head4) * 17 + 16) * 8192 : p.DKp + ((size_t)(bseq * 4 + head4) * 128 + (t0 >> 6)) * 8192) + (t0 & 63) * 128 + colh;
#pragma unroll
                for (int i = 0; i < 16; ++i) { const size_t ro = (size_t)crow(i, h) * 512; __builtin_nontemporal_store(v0[i], ko + ro); __builtin_nontemporal_store(v1[i], ko + ro + 32); }
                stage_store(stg, v0, v1, kb, 128, lane, false);
            }
        } else {
            float* vo = (samp ? p.out + O_VS + (size_t)(tok0 - TP) * 512 : p.out + O_VP + (size_t)tok0 * 512) + cseg0 + r;
            const int head4 = cseg0 >> 7, dv0 = cseg0 & 127;
            u16* tb = (samp ? p.SVt + ((size_t)(bseq * 4 + head4) * 17 + 16) * 8192 : p.DVtp + ((size_t)(bseq * 4 + head4) * 128 + (t0 >> 6)) * 8192) + dv0 * 64 + (t0 & 63);
#pragma unroll
            for (int i = 0; i < 16; ++i) { v0[i] = acc[mi][0][i]; v1[i] = acc[mi][1][i]; const size_t ro = (size_t)crow(i, h) * 512; __builtin_nontemporal_store(v0[i], vo + ro); __builtin_nontemporal_store(v1[i], vo + ro + 32); }
            store_tr(tb, v0, v1, r, h, false);
        }
    }
}

template <int MI> DI void gemm_issue0(const u16* __restrict__ Ag, const u16* __restrict__ Bg, u32x4 (&ra)[MI], u32x4 (&rb)[2], int tid) {
    const int lrow = tid >> 2, lch = tid & 3;
    const u16* ag = Ag + (size_t)lrow * 1024 + lch * 8; const u16* bg = Bg + (size_t)lrow * 1024 + lch * 8;
#pragma unroll
    for (int i = 0; i < MI; ++i) ra[i] = *(const u32x4*)(ag + (size_t)i * 64 * 1024);
#pragma unroll
    for (int i = 0; i < 2; ++i) rb[i] = *(const u32x4*)(bg + (size_t)i * 64 * 1024);
}
template <int MI, bool PRE = false> DI void gemm_core(const u16* __restrict__ Ag, const u16* __restrict__ Bg, u16* smem16, f32x16 (&acc)[MI][2], int tid, u32x4 (&ra)[MI], u32x4 (&rb)[2]) {
    constexpr int AST = 64 * MI * 40, STAGE = AST + 128 * 40;
    const int lane = tid & 63, wid = tid >> 6, r = lane & 31, h = lane >> 5, wm = wid >> 1, wn = wid & 1, lrow = tid >> 2, lch = tid & 3;
    const u16* ag = Ag + (size_t)lrow * 1024 + lch * 8; const u16* bg = Bg + (size_t)lrow * 1024 + lch * 8;
    const int wofs = lrow * 40 + lch * 8;
    const int afo = (32 * MI * wm + r) * 40 + 8 * h, bfo = AST + (64 * wn + r) * 40 + 8 * h;
#pragma unroll
    for (int a = 0; a < MI; ++a) { acc[a][0] = zero16(); acc[a][1] = zero16(); }
    if (!PRE) {
#pragma unroll
        for (int i = 0; i < MI; ++i) ra[i] = *(const u32x4*)(ag + (size_t)i * 64 * 1024);
#pragma unroll
        for (int i = 0; i < 2; ++i) rb[i] = *(const u32x4*)(bg + (size_t)i * 64 * 1024);
    }
    __syncthreads();
#pragma unroll
    for (int i = 0; i < MI; ++i) *(u32x4*)(smem16 + wofs + i * 64 * 40) = ra[i];
#pragma unroll
    for (int i = 0; i < 2; ++i) *(u32x4*)(smem16 + AST + wofs + i * 64 * 40) = rb[i];
#pragma unroll
    for (int i = 0; i < MI; ++i) ra[i] = *(const u32x4*)(ag + (size_t)i * 64 * 1024 + 32);
#pragma unroll
    for (int i = 0; i < 2; ++i) rb[i] = *(const u32x4*)(bg + (size_t)i * 64 * 1024 + 32);
    __syncthreads();
    for (int kt = 0; kt < 32; ++kt) {
        const u16* cur = smem16 + (kt & 1) * STAGE;
        u16* nxt = smem16 + ((kt & 1) ^ 1) * STAGE;
        bf16x8 a0[MI], b0[2], a1[MI], b1[2];
#pragma unroll
        for (int mi = 0; mi < MI; ++mi) a0[mi] = *(const bf16x8*)(cur + afo + mi * 32 * 40);
#pragma unroll
        for (int ni = 0; ni < 2; ++ni) b0[ni] = *(const bf16x8*)(cur + bfo + ni * 32 * 40);
        __builtin_amdgcn_sched_barrier(0);
        if (kt < 31) {
#pragma unroll
            for (int i = 0; i < MI; ++i) *(u32x4*)(nxt + wofs + i * 64 * 40) = ra[i];
#pragma unroll
            for (int i = 0; i < 2; ++i) *(u32x4*)(nxt + AST + wofs + i * 64 * 40) = rb[i];
            if (kt < 30) {
#pragma unroll
                for (int i = 0; i < MI; ++i) ra[i] = *(const u32x4*)(ag + (size_t)i * 64 * 1024 + (kt + 2) * 32);
#pragma unroll
                for (int i = 0; i < 2; ++i) rb[i] = *(const u32x4*)(bg + (size_t)i * 64 * 1024 + (kt + 2) * 32);
            }
        }
#pragma unroll
        for (int mi = 0; mi < MI; ++mi) a1[mi] = *(const bf16x8*)(cur + afo + mi * 32 * 40 + 16);
#pragma unroll
        for (int ni = 0; ni < 2; ++ni) b1[ni] = *(const bf16x8*)(cur + bfo + ni * 32 * 40 + 16);
        __builtin_amdgcn_sched_barrier(0);
#pragma unroll
        for (int mi = 0; mi < MI; ++mi) { acc[mi][0] = MFMA32(a0[mi], b0[0], acc[mi][0]); acc[mi][1] = MFMA32(a0[mi], b0[1], acc[mi][1]); }
#pragma unroll
        for (int mi = 0; mi < MI; ++mi) { acc[mi][0] = MFMA32(a1[mi], b1[0], acc[mi][0]); acc[mi][1] = MFMA32(a1[mi], b1[1], acc[mi][1]); }
        __syncthreads();
    }
}

DI void p1_map(int tile, int& mt, int& nt) {
    mt = tile >> 5; nt = tile & 31;
    if (tile < 4096 && (gridDim.x & 511) == 0) {
        const int rnd = tile >> 9, b = tile & 511, x = b & 7, idx = b >> 3;
        mt = rnd * 16 + 4 * (x >> 1) + (idx >> 4); nt = 16 * (x & 1) + (idx & 15);
    }
}
__device__ void p1_gemm(const Params& p, unsigned char* smem) {
    u32x4 ra[4], rb[2];
    if ((int)blockIdx.x < 136 * 32 * REP1) { int mt0, nt0; p1_map((int)blockIdx.x % (136 * 32), mt0, nt0); gemm_issue0<4>(p.H + (size_t)mt0 * 256 * 1024, p.WtIn + (size_t)nt0 * 128 * 1024, ra, rb, threadIdx.x); }
    for (int tile_ = blockIdx.x; tile_ < 136 * 32 * REP1; tile_ += gridDim.x) {
        int tid = threadIdx.x; asm volatile("" : "+v"(tid));
        int mt, nt; p1_map(tile_ % (136 * 32), mt, nt);
        f32x16 acc[4][2];
        gemm_core<4, true>(p.H + (size_t)mt * 256 * 1024, p.WtIn + (size_t)nt * 128 * 1024, (u16*)smem, acc, tid, ra, rb);
        if (tile_ + (int)gridDim.x < 136 * 32 * REP1) { int mt2, nt2; p1_map((tile_ + (int)gridDim.x) % (136 * 32), mt2, nt2); gemm_issue0<4>(p.H + (size_t)mt2 * 256 * 1024, p.WtIn + (size_t)nt2 * 128 * 1024, ra, rb, tid); }
        __syncthreads();
        p1_epilogue<4>(p, acc, mt, nt, (tid >> 6) >> 1, (tid >> 6) & 1, tid & 63, (float*)smem + (tid >> 6) * (32 * 68));
    }
    {
        int tid = threadIdx.x; asm volatile("" : "+v"(tid));
        int* s_item = (int*)(smem + 73728);
        float* tile0 = (float*)smem; float* tile1 = tile0 + 64 * 65;
        for (;;) {
            __syncthreads();
            if (tid == 0) *s_item = (int)atomicAdd(p.ctr + 8 * 32, 1u);
            __syncthreads();
            const int j = __builtin_amdgcn_readfirstlane(*s_item);
            if (j >= 4096) break;
            if (j < 2048) {
                const TJob j0 = tjob(p, 1280 + 2 * j), j1 = tjob(p, 1280 + 2 * j + 1);
                f32x4 v0[4], v1[4];
                tr_load(j0, v0, tid); tr_load(j1, v1, tid);
                tr_put(v0, tile0, tid); tr_put(v1, tile1, tid);
                __syncthreads();
                tr_store(j0, tile0, tid); tr_store(j1, tile1, tid);
            } else {
                const size_t base = (size_t)(j - 2048) * 2048;
                f32x4 v[8];
#pragma unroll
                for (int q = 0; q < 8; ++q) v[q] = __builtin_nontemporal_load((const f32x4*)(p.cache_k + (base + tid + 256 * q) * 4));
#pragma unroll
                for (int q = 0; q < 8; ++q) {
                    const size_t i = base + tid + 256 * q, row = i >> 7; const int c4 = (int)(i & 127), sb = (int)(row >> 10), t = (int)(row & 1023);
                    u32x2 w; w.x = pk2(v[q].x, v[q].y); w.y = pk2(v[q].z, v[q].w);
                    *(u32x2*)(p.SK + ((size_t)(sb * 4 + (c4 >> 5)) * 17 + (t >> 6)) * 8192 + (t & 63) * 128 + (c4 & 31) * 4) = w;
                }
            }
        }
    }
}

constexpr int KV_STAGE = 2 * 128 * 72;
__device__ void attn_unit(const Params& p, unsigned char* smem, const u16* __restrict__ qptr, const u16* __restrict__ kptr, const u16* __restrict__ vtptr,
                          int ntiles, int tok0, int head) {
    u16* sKV = (u16*)smem;
    int tid = threadIdx.x; asm volatile("" : "+v"(tid)); const int lane = tid & 63, wid = tid >> 6, r = lane & 31, h = lane >> 5, c = wid & 1, rg = wid >> 1;
    bf16x8 qf[4];
#pragma unroll
    for (int ks = 0; ks < 4; ++ks) qf[ks] = *(const bf16x8*)(qptr + (size_t)(32 * rg + r) * 512 + c * 64 + 16 * ks + 8 * h);
    f32x16 O[4];
#pragma unroll
    for (int i = 0; i < 4; ++i) O[i] = zero16();
    float m = -1e30f, l = 0.f;
    const int kkey = tid >> 4, kcc = tid & 15;
    const int vdv = tid >> 3, vch = tid & 7;
    const u16* kg = kptr + tid * 8;
    const u16* vg = vtptr + tid * 8;
    const int klo = ((kcc >> 3) * 64 + kkey) * 72 + (kcc & 7) * 8;
    const int vlo = 128 * 72 + vdv * 72 + vch * 8;
    const int kfo = (c * 64 + r) * 72 + 8 * h;
    const int vfo = 128 * 72 + r * 72 + 8 * h;
    u32x4 rk[4], rv[4];
#pragma unroll
    for (int i = 0; i < 4; ++i) { rk[i] = *(const u32x4*)(kg + i * 2048); rv[i] = *(const u32x4*)(vg + i * 2048); }
    __syncthreads();
#pragma unroll
    for (int i = 0; i < 4; ++i) { *(u32x4*)(sKV + klo + i * 16 * 72) = rk[i]; *(u32x4*)(sKV + vlo + i * 32 * 72) = rv[i]; }
    if (ntiles > 1) {
#pragma unroll
        for (int i = 0; i < 4; ++i) { rk[i] = *(const u32x4*)(kg + 8192 + i * 2048); rv[i] = *(const u32x4*)(vg + 8192 + i * 2048); }
    }
    __syncthreads();
    for (int kt = 0; kt < ntiles; ++kt) {
        const u16* cur = sKV + (kt & 1) * KV_STAGE;
        u16* nxt = sKV + ((kt & 1) ^ 1) * KV_STAGE;
        bf16x8 kf[2][4];
#pragma unroll
        for (int ks = 0; ks < 4; ++ks) { kf[0][ks] = *(const bf16x8*)(cur + kfo + 16 * ks); kf[1][ks] = *(const bf16x8*)(cur + kfo + 32 * 72 + 16 * ks); }
        __builtin_amdgcn_sched_barrier(0);
        f32x16 S0 = zero16(), S1 = zero16();
#pragma unroll
        for (int ks = 0; ks < 4; ++ks) { S0 = MFMA32(kf[0][ks], qf[ks], S0); S1 = MFMA32(kf[1][ks], qf[ks], S1); __builtin_amdgcn_sched_barrier(0); }
        bf16x8 va[4][2];
#pragma unroll
        for (int d = 0; d < 4; ++d)
#pragma unroll
            for (int q = 0; q < 2; ++q) va[d][q] = *(const bf16x8*)(cur + vfo + d * 32 * 72 + 16 * q);
        if (kt + 1 < ntiles) {
#pragma unroll
            for (int i = 0; i < 4; ++i) { *(u32x4*)(nxt + klo + i * 16 * 72) = rk[i]; *(u32x4*)(nxt + vlo + i * 32 * 72) = rv[i]; }
            if (kt + 2 < ntiles) {
#pragma unroll
                for (int i = 0; i < 4; ++i) { rk[i] = *(const u32x4*)(kg + (size_t)(kt + 2) * 8192 + i * 2048); rv[i] = *(const u32x4*)(vg + (size_t)(kt + 2) * 8192 + i * 2048); }
            }
        }
        __builtin_amdgcn_sched_barrier(0);
        float mt = fmaxf(S0[0], S1[0]);
#pragma unroll
        for (int i = 1; i < 16; ++i) mt = fmaxf(mt, fmaxf(S0[i], S1[i]));
        mt = xhalf_max(mt);
        if (__any(mt > m)) {
            const float mn = fmaxf(m, mt), al = __builtin_amdgcn_exp2f(m - mn);
            m = mn; l *= al;
#pragma unroll
            for (int d = 0; d < 4; ++d)
#pragma unroll
                for (int i = 0; i < 16; ++i) O[d][i] *= al;
        }
        const f32x2 m2 = {m, m};
        f32x2 l2 = {0.f, 0.f};
        u32x4 pw[4];
#pragma unroll
        for (int j = 0; j < 8; ++j) {
            f32x2 x0 = {S0[2 * j], S0[2 * j + 1]};
            x0 = x0 - m2;
            f32x2 e0; e0.x = __builtin_amdgcn_exp2f(x0.x); e0.y = __builtin_amdgcn_exp2f(x0.y);
            l2 = l2 + e0;
            pw[j >> 2][j & 3] = pk2(e0.x, e0.y);
        }
        const bf16x8 p00 = __builtin_bit_cast(bf16x8, pw[0]), p01 = __builtin_bit_cast(bf16x8, pw[1]);
        bf16x8 vb[4][2];
#pragma unroll
        for (int d = 0; d < 4; ++d)
#pragma unroll
            for (int q = 0; q < 2; ++q) vb[d][q] = *(const bf16x8*)(cur + vfo + d * 32 * 72 + 32 + 16 * q);
#pragma unroll
        for (int j = 0; j < 8; ++j) {
            O[j & 3] = MFMA32(va[j & 3][j >> 2], (j >> 2) ? p01 : p00, O[j & 3]);
            f32x2 x1 = {S1[2 * j], S1[2 * j + 1]};
            x1 = x1 - m2;
            f32x2 e1; e1.x = __builtin_amdgcn_exp2f(x1.x); e1.y = __builtin_amdgcn_exp2f(x1.y);
            l2 = l2 + e1;
            pw[2 + (j >> 2)][j & 3] = pk2(e1.x, e1.y);
        }
        l += l2.x + l2.y;
        const bf16x8 p10 = __builtin_bit_cast(bf16x8, pw[2]), p11 = __builtin_bit_cast(bf16x8, pw[3]);
#pragma unroll
        for (int j = 0; j < 8; ++j) O[j & 3] = MFMA32(vb[j & 3][j >> 2], (j >> 2) ? p11 : p10, O[j & 3]);
        __syncthreads();
    }
    const float inv = 1.f / xhalf_sum(l);
    const float lam = p.misc[0];
    float* ex = (float*)smem + rg * 4096;
    if (c == 1) {
        const float sc = inv * lam;
#pragma unroll
        for (int d = 0; d < 4; ++d)
#pragma unroll
            for (int i = 0; i < 16; ++i) ex[(d * 16 + i) * 64 + lane] = O[d][i] * sc;
    }
    __syncthreads();
    if (c == 0) {
        float ss = 0.f;
#pragma unroll
        for (int d = 0; d < 4; ++d)
#pragma unroll
            for (int i = 0; i < 16; ++i) { const float v = O[d][i] * inv - ex[(d * 16 + i) * 64 + lane]; O[d][i] = v; ss += v * v; }
        ss += __shfl_xor(ss, 32);
        const float rstd = rsqrtf(ss * (1.f / 128.f) + EPS) * 0.8f;
        const size_t tok = (size_t)(tok0 + 32 * rg + r);
#pragma unroll
        for (int d = 0; d < 4; ++d)
#pragma unroll
            for (int g = 0; g < 4; ++g) {
                const int dv0 = 32 * d + 8 * g + 4 * h;
                const u32x2 gt = *(const u32x2*)(p.DG + tok * 512 + head * 128 + dv0);
                const f32x4 gn = *(const f32x4*)(p.diff_norm_g + dv0);
                u32x2 w;
                w.x = pk2(O[d][4 * g + 0] * rstd * gn.x * bf2f(gt.x & 0xffffu), O[d][4 * g + 1] * rstd * gn.y * bf2f(gt.x >> 16));
                w.y = pk2(O[d][4 * g + 2] * rstd * gn.z * bf2f(gt.y & 0xffffu), O[d][4 * g + 3] * rstd * gn.w * bf2f(gt.y >> 16));
                *(u32x2*)(p.MIX + tok * 1024 + 512 + head * 128 + dv0) = w;
            }
    }
}

__device__ void ret_scan_item(const Params& p, int seqi, int hd) {
    int tid = threadIdx.x; asm volatile("" : "+v"(tid)); const int lane = tid & 63, wid = tid >> 6, r = lane & 31, h = lane >> 5, dvb = wid >> 1, dkb = wid & 1;
    const bool samp = seqi >= 4; const int sb = seqi - 4;
    const size_t tbase = samp ? TR_S_OFF + (size_t)(sb * 8 + hd) * 4096 : ((size_t)(seqi * 8 + hd) * 128) * 4096;
    const u16* vt = p.RVt + tbase + (size_t)(32 * dvb + r) * 64 + 8 * h;
    const u16* kt = p.RKtd + tbase + (size_t)(32 * dkb + r) * 64 + 8 * h;
    const int nch = samp ? 1 : 128;
    u16* sprev = p.SPREV + (size_t)(samp ? 4096 + sb * 8 + hd : (seqi * 8 + hd) * 128) * 4096;
    float* so = samp ? p.out + O_SS + (size_t)(sb * 8 + hd) * 4096 : p.out + O_SP + (size_t)(seqi * 8 + hd) * 4096;
    const int dk = 32 * dkb + r;
    f32x16 S = zero16();
    if (samp) {
        const float* si = p.state_ret + (size_t)(sb * 8 + hd) * 4096 + (size_t)dk * 64 + 32 * dvb + 4 * h;
#pragma unroll
        for (int g = 0; g < 4; ++g) { const f32x4 v = *(const f32x4*)(si + 8 * g); S[4 * g] = v.x; S[4 * g + 1] = v.y; S[4 * g + 2] = v.z; S[4 * g + 3] = v.w; }
    }
    const float g64 = exp2f(log2_gamma(hd) * 64.f);
    bf16x8 an[4], bn[4];
#pragma unroll
    for (int ks = 0; ks < 4; ++ks) { an[ks] = *(const bf16x8*)(vt + 16 * ks); bn[ks] = *(const bf16x8*)(kt + 16 * ks); }
    for (int c = 0; c < nch; ++c) {
        bf16x8 a[4], b[4];
#pragma unroll
        for (int ks = 0; ks < 4; ++ks) { a[ks] = an[ks]; b[ks] = bn[ks]; }
        if (c + 1 < nch) {
#pragma unroll
            for (int ks = 0; ks < 4; ++ks) { an[ks] = *(const bf16x8*)(vt + (size_t)(c + 1) * 4096 + 16 * ks); bn[ks] = *(const bf16x8*)(kt + (size_t)(c + 1) * 4096 + 16 * ks); }
        }
#pragma unroll
        for (int i = 0; i < 16; ++i) sprev[(size_t)c * 4096 + (32 * dvb + crow(i, h)) * 64 + dk] = f2bf(S[i]);
        f32x16 KV = zero16();
#pragma unroll
        for (int ks = 0; ks < 4; ++ks) KV = MFMA32(a[ks], b[ks], KV);
#pragma unroll
        for (int i = 0; i < 16; ++i) S[i] = g64 * S[i] + KV[i];
    }
#pragma unroll
    for (int g = 0; g < 4; ++g) { f32x4 v = {S[4 * g], S[4 * g + 1], S[4 * g + 2], S[4 * g + 3]}; *(f32x4*)(so + (size_t)dk * 64 + 32 * dvb + 4 * h + 8 * g) = v; }
    asm volatile("s_waitcnt vmcnt(0)" ::: "memory");
    __syncthreads();
    if (tid == 0) {
        __builtin_amdgcn_fence(__ATOMIC_RELEASE, "agent");
        asm volatile("s_waitcnt vmcnt(0)" ::: "memory");
        __hip_atomic_fetch_add(p.done + seqi * 2 + (hd >> 2), 1u, __ATOMIC_RELAXED, __HIP_MEMORY_SCOPE_AGENT);
    }
}

__device__ void p3_tile(const Params& p, int tile, int hh) {
    int tid = threadIdx.x;
    asm volatile("" : "+v"(tid));
    const int lane = tid & 63, wid = tid >> 6, r = lane & 31, h = lane >> 5;
    int hf, tokc, unit0, ustride; size_t vtb, L, pos0;
    if (tile < 1024) { const int b = tile >> 8, c = (tile >> 1) & 127; hf = tile & 1; tokc = b * 8192 + c * 64; unit0 = (b * 8) * 128 + c; ustride = 128; vtb = ((size_t)(b * 8) * 128 + c) * 4096; L = 128 * 4096; pos0 = 0; }
    else { const int k = tile - 1024, sb = k >> 1; hf = k & 1; tokc = TP + sb * 64; unit0 = 4096 + sb * 8; ustride = 1; vtb = TR_S_OFF + (size_t)(sb * 8) * 4096; L = 4096; pos0 = 0; }
    const int tok0 = tokc + 32 * hf;
    const int qi = 32 * hf + r;
    {
        const int hd = 4 * hh + wid;
        const float lg = log2_gamma(hd);
        bf16x8 qf[4];
#pragma unroll
        for (int ks = 0; ks < 4; ++ks) qf[ks] = *(const bf16x8*)(p.RQ + (size_t)(tok0 + r) * 512 + hd * 64 + 16 * ks + 8 * h);
        __builtin_amdgcn_sched_barrier(0);
        f32x16 S0 = zero16(), S1 = zero16();
#pragma unroll
        for (int ks = 0; ks < 4; ++ks) S0 = MFMA32(*(const bf16x8*)(p.RK + (size_t)(tokc + r) * 512 + hd * 64 + 16 * ks + 8 * h), qf[ks], S0);
        if (hf) {
#pragma unroll
            for (int ks = 0; ks < 4; ++ks) S1 = MFMA32(*(const bf16x8*)(p.RK + (size_t)(tokc + 32 + r) * 512 + hd * 64 + 16 * ks + 8 * h), qf[ks], S1);
        }
#pragma unroll
        for (int i = 0; i < 16; ++i) {
            const int k0 = crow(i, h), k1 = 32 + k0;
            S0[i] = qi >= k0 ? S0[i] * __builtin_amdgcn_exp2f(lg * (float)(qi - k0)) : 0.f;
            S1[i] = qi >= k1 ? S1[i] * __builtin_amdgcn_exp2f(lg * (float)(qi - k1)) : 0.f;
        }
        const bf16x8 p00 = pack8<0>(S0), p01 = pack8<1>(S0), p10 = pack8<0>(S1), p11 = pack8<1>(S1);
        __builtin_amdgcn_sched_barrier(0);
        const float qd = __builtin_amdgcn_exp2f(lg * (float)(qi + 1));
        const u16* vt = p.RVt + vtb + (size_t)hd * L + pos0 + 8 * h;
        const u16* sp = p.SPREV + (size_t)(unit0 + hd * ustride) * 4096 + 8 * h;
        float ss = 0.f;
        f32x16 o[2];
#pragma unroll
        for (int d = 0; d < 2; ++d) {
            f32x16 in = zero16(), cr = zero16();
            const u16* vr = vt + (size_t)(32 * d + r) * 64;
            in = MFMA32(*(const bf16x8*)(vr), p00, in);
            in = MFMA32(*(const bf16x8*)(vr + 16), p01, in);
            if (hf) { in = MFMA32(*(const bf16x8*)(vr + 32), p10, in); in = MFMA32(*(const bf16x8*)(vr + 48), p11, in); }
#pragma unroll
            for (int ks = 0; ks < 4; ++ks) cr = MFMA32(*(const bf16x8*)(sp + (32 * d + r) * 64 + 16 * ks), qf[ks], cr);
#pragma unroll
            for (int i = 0; i < 16; ++i) { const float v = in[i] + cr[i] * qd; o[d][i] = v; ss += v * v; }
            __builtin_amdgcn_sched_barrier(0);
        }
        ss += __shfl_xor(ss, 32);
        const float rstd = rsqrtf(ss * (1.f / 64.f) + EPS);
#pragma unroll
        for (int d = 0; d < 2; ++d)
#pragma unroll
            for (int g = 0; g < 4; ++g) {
                const int dv0 = 32 * d + 8 * g + 4 * h;
                const u32x2 gt = *(const u32x2*)(p.RG + (size_t)(tok0 + r) * 512 + hd * 64 + dv0);
                const f32x4 gn = *(const f32x4*)(p.ret_norm_g + hd * 64 + dv0);
                u32x2 w;
                w.x = pk2(o[d][4 * g + 0] * rstd * gn.x * bf2f(gt.x & 0xffffu), o[d][4 * g + 1] * rstd * gn.y * bf2f(gt.x >> 16));
                w.y = pk2(o[d][4 * g + 2] * rstd * gn.z * bf2f(gt.y & 0xffffu), o[d][4 * g + 3] * rstd * gn.w * bf2f(gt.y >> 16));
                *(u32x2*)(p.MIX + (size_t)(tok0 + r) * 1024 + hd * 64 + dv0) = w;
            }
    }
}


constexpr int XQ_ITEMS = 4 + 32 + 256 + 16 + 256 + 16;
DI void wait_done(const Params& p, int idx, int tid) {
    if (tid == 0) {
        unsigned sp = 0;
        while (__hip_atomic_load(p.done + idx, __ATOMIC_RELAXED, __HIP_MEMORY_SCOPE_AGENT) < 4u) { __builtin_amdgcn_s_sleep(2); if (++sp > (1u << 22)) break; }
        __builtin_amdgcn_fence(__ATOMIC_ACQUIRE, "agent");
        asm volatile("s_waitcnt vmcnt(0)" ::: "memory");
    }
    __syncthreads();
}
__device__ void p2_mix(const Params& p, unsigned char* smem) {
    int* s_item = (int*)(smem + 73728);
    int tid = threadIdx.x; asm volatile("" : "+v"(tid));
    const int xcc = (int)(xb_xcc_id() & 7u);
    for (int q = 0; q < 8; ++q) {
        const int x = (xcc + q) & 7;
        while (true) {
            __syncthreads();
            if (tid == 0) *s_item = (int)atomicAdd(p.ctr + x * 32, 1u);
            __syncthreads();
            const int it = __builtin_amdgcn_readfirstlane(*s_item);
            if (it >= XQ_ITEMS) break;
            int kind, arg;
            if (it < 4) { kind = 0; arg = it; }
            else if (it < 36) { kind = 4; arg = it - 4; }
            else if (it < 228) { kind = 1; arg = it - 36; }
            else if (it < 244) { kind = 2; arg = it - 228; }
            else if (it < 564) { const int g = (it - 244) / 10, e = (it - 244) % 10; if (e < 2) { kind = 1; arg = 192 + 2 * g + e; } else { kind = 3; arg = 8 * g + (e - 2); } }
            else { kind = 3; arg = 256 + (it - 564); }
            if (kind == 0) { const int s = 4 * x + arg; ret_scan_item(p, s >> 3, s & 7); }
            else if (kind == 4) { const int k = 32 * x + arg; ret_scan_item(p, 4 + (k >> 3), k & 7); }
            else if (kind == 1) {
                const int k = arg, j = 127 - (k >> 1), bh = 2 * x + (k & 1), b = bh >> 2, hh = bh & 3;
                const int tok0 = b * 8192 + j * 64;
                attn_unit(p, smem, p.DQ + (size_t)tok0 * 512 + hh * 128, p.DKp + (size_t)(bh * 128) * 8192, p.DVtp + (size_t)(bh * 128) * 8192, j + 1, tok0, hh);
            } else if (kind == 2) {
                const int k = 16 * x + arg, sb = k >> 2, hh = k & 3;
                const int tok0 = TP + sb * 64;
                attn_unit(p, smem, p.DQ + (size_t)tok0 * 512 + hh * 128, p.SK + (size_t)(k * 17) * 8192, p.SVt + (size_t)(k * 17) * 8192, 17, tok0, hh);
            } else if (arg < 256) {
                const int b = x >> 1, hh = x & 1;
                wait_done(p, b * 2 + hh, tid);
                p3_tile(p, b * 256 + arg, hh);
            } else {
                const int k = arg - 256, sb = 4 * x + (k >> 2), hf = (k >> 1) & 1, hh = k & 1;
                wait_done(p, (4 + sb) * 2 + hh, tid);
                p3_tile(p, 1024 + sb * 2 + hf, hh);
            }
        }
    }
}

template <int MI> DI void p5_tile(const Params& p, unsigned char* smem, int row0, int nt, int tid) {
    f32x16 acc[MI][2];
    u32x4 ra_[MI], rb_[2];
    gemm_core<MI>(p.MIX + (size_t)row0 * 1024, p.WtOut + (size_t)nt * 128 * 1024, (u16*)smem, acc, tid, ra_, rb_);
    const int lane = tid & 63, wid = tid >> 6, r = lane & 31, h = lane >> 5, wm = wid >> 1, wn = wid & 1;
    float* red = (float*)smem;
    __syncthreads();
#pragma unroll
    for (int mi = 0; mi < MI; ++mi) {
        const int rl = wm * 32 * MI + mi * 32, tok0 = row0 + rl;
        const float* xb = (tok0 < TP ? p.x_p + (size_t)tok0 * D : p.x_s + (size_t)(tok0 - TP) * D) + nt * 128 + wn * 64 + r;
        float* yb = p.out + O_Y + (size_t)tok0 * D + nt * 128 + wn * 64 + r;
#pragma unroll
        for (int i = 0; i < 16; ++i) {
            const size_t ro = (size_t)crow(i, h) * D;
            const float v0 = acc[mi][0][i] + __builtin_nontemporal_load(xb + ro), v1 = acc[mi][1][i] + __builtin_nontemporal_load(xb + ro + 32);
            yb[ro] = v0; yb[ro + 32] = v1;
            float s = v0 * v0 + v1 * v1;
#pragma unroll
            for (int o = 1; o <= 16; o <<= 1) s += __shfl_xor(s, o);
            if (r == 0) red[wn * 64 * MI + rl + crow(i, h)] = s;
        }
    }
    __syncthreads();
    if (tid < 64 * MI) unsafeAtomicAdd(p.rowss + row0 + tid, red[tid] + red[64 * MI + tid]);
}
__device__ void p5_gemm(const Params& p, unsigned char* smem) {
    for (int tile_ = blockIdx.x; tile_ < (1024 + 256) * REP5; tile_ += gridDim.x) {
        int tid = threadIdx.x; asm volatile("" : "+v"(tid));
        const int tile = tile_ % (1024 + 256);
        if (tile < 1024) p5_tile<4>(p, smem, (tile >> 3) * 256, tile & 7, tid);
        else { const int t = tile - 1024; p5_tile<1>(p, smem, TP + (t >> 3) * 64, t & 7, tid); }
    }
}

__device__ void p6_norm(const Params& p) {
    const int tid = threadIdx.x, lane = tid & 63, wid = tid >> 6;
    f32x4 g[4];
#pragma unroll
    for (int i = 0; i < 4; ++i) g[i] = *(const f32x4*)(p.final_g + (lane + 64 * i) * 4);
    for (int row = (blockIdx.x * 4 + wid) * 2; row < T; row += gridDim.x * 8) {
        f32x4 v[2][4];
#pragma unroll
        for (int q = 0; q < 2; ++q)
#pragma unroll
            for (int i = 0; i < 4; ++i) v[q][i] = __builtin_nontemporal_load((const f32x4*)(p.out + O_Y + (size_t)(row + q) * D + (lane + 64 * i) * 4));
#pragma unroll
        for (int q = 0; q < 2; ++q) {
            const float rs = rsqrtf(p.rowss[row + q] * (1.f / 1024.f) + EPS);
#pragma unroll
            for (int i = 0; i < 4; ++i) { f32x4 o = v[q][i] * g[i] * rs; __builtin_nontemporal_store(o, (f32x4*)(p.out + O_Y + (size_t)(row + q) * D + (lane + 64 * i) * 4)); }
        }
    }
}

#define SMEM_DECL __shared__ __attribute__((aligned(16))) unsigned char smem[LDS_BYTES]
#if MULTI_LAUNCH
__global__ void __launch_bounds__(NTHREADS, 2) k_p0(Params p) { SMEM_DECL; p0_prep(p, smem); }
__global__ void __launch_bounds__(NTHREADS, 2) k_p1(Params p) { SMEM_DECL; p1_gemm(p, smem); }
__global__ void __launch_bounds__(NTHREADS, 2) k_p2(Params p) { SMEM_DECL; p2_mix(p, smem); }
__global__ void __launch_bounds__(NTHREADS, 2) k_p5(Params p) { SMEM_DECL; p5_gemm(p, smem); }
__global__ void __launch_bounds__(NTHREADS, 2) k_p6(Params p) { p6_norm(p); }
#else
__global__ void __launch_bounds__(NTHREADS, 2) fwd_megakernel(Params p) {
    SMEM_DECL;
    __shared__ uint4 xb_words;
    cg::grid_group grid = cg::this_grid();
    if (p.never) grid.sync();
    if (threadIdx.x == 0) xb_words = make_uint4(0u, 0u, 0u, 0u);
    __syncthreads();
    const XcdBarrier xb = xcd_barrier_post(p.bar, (volatile LAS unsigned*)&xb_words);
#pragma nounroll
    for (int rep = 0; rep < REP0; ++rep) p0_prep(p, smem);
    xcd_barrier(xb);
    p1_gemm(p, smem);
    xcd_barrier(xb);
    p2_mix(p, smem);
    xcd_barrier(xb);
    p5_gemm(p, smem);
    xcd_barrier(xb);
    p6_norm(p);
}
#endif

extern "C" void kernel_launch(void* const* d_in, const int* in_sizes, int n_in, void* d_out, int out_size, void* d_ws, size_t ws_size, hipStream_t stream) {
    Params p{};
    p.x_p = (const float*)d_in[0]; p.x_s = (const float*)d_in[1]; p.cache_k = (const float*)d_in[2]; p.cache_v = (const float*)d_in[3]; p.state_ret = (const float*)d_in[4];
    p.norm_g = (const float*)d_in[5]; p.w_in = (const float*)d_in[6]; p.w_out = (const float*)d_in[7]; p.ret_norm_g = (const float*)d_in[8]; p.diff_norm_g = (const float*)d_in[9];
    p.lam_q1 = (const float*)d_in[10]; p.lam_k1 = (const float*)d_in[11]; p.lam_q2 = (const float*)d_in[12]; p.lam_k2 = (const float*)d_in[13]; p.final_g = (const float*)d_in[14];
    p.out = (float*)d_out;
    unsigned char* w = (unsigned char*)d_ws; size_t off = 0;
    auto take = [&](size_t bytes) { unsigned char* r = w + off; off += (bytes + 255) & ~(size_t)255; return r; };
    const size_t HALF = (size_t)T * 512 * 2;
    p.H = (u16*)take(2 * HALF);
    p.MIX = p.H; p.SPREV = (u16*)take(HALF);
    p.WtIn = (u16*)take((size_t)4096 * 1024 * 2); p.WtOut = (u16*)take((size_t)1024 * 1024 * 2);
    p.RQ = (u16*)take(HALF); p.RK = (u16*)take(HALF); p.RKtd = (u16*)take(HALF); p.RVt = (u16*)take(HALF); p.RG = (u16*)take(HALF); p.DQ = (u16*)take(HALF); p.DG = (u16*)take(HALF);
    p.cosR = (float*)take(8192 * 32 * 4); p.sinR = (float*)take(8192 * 32 * 4); p.cosD = (float*)take(8192 * 8 * 4); p.sinD = (float*)take(8192 * 8 * 4);
    p.misc = (float*)take(256); p.ctr = (unsigned*)take(2048); p.done = (unsigned*)take(512); p.rowss = (float*)take((size_t)T * 4); p.bar = (unsigned*)take(XCD_BAR_WORDS * 4);
    unsigned char* yo = (unsigned char*)d_out; size_t yoff = 0;
    auto takey = [&](size_t bytes) { unsigned char* r = yo + yoff; yoff += (bytes + 255) & ~(size_t)255; return r; };
    p.DKp = (u16*)takey((size_t)TP * 512 * 2); p.SK = (u16*)takey((size_t)32 * SKL * 512 * 2); p.DVtp = (u16*)takey((size_t)2048 * 8192 * 2); p.SVt = (u16*)takey((size_t)16384 * SKL * 2);
    if (off > ws_size || yoff > (size_t)35651584 * 4) { fprintf(stderr, "workspace too small: need %zu have %zu\n", off, ws_size); return; }
#if MULTI_LAUNCH
    static int gb = 0;
    if (!gb) { int dev = 0, cus = 0; hipGetDevice(&dev); hipDeviceGetAttribute(&cus, hipDeviceAttributeMultiprocessorCount, dev); gb = cus * 2; }
    k_p0<<<gb, NTHREADS, 0, stream>>>(p); k_p1<<<gb, NTHREADS, 0, stream>>>(p); k_p2<<<gb, NTHREADS, 0, stream>>>(p); k_p5<<<gb, NTHREADS, 0, stream>>>(p); k_p6<<<gb, NTHREADS, 0, stream>>>(p);
#else
    static int grid_blocks = 0;
    if (!grid_blocks) {
        int dev = 0, cus = 0, per_cu = 0;
        hipGetDevice(&dev); hipDeviceGetAttribute(&cus, hipDeviceAttributeMultiprocessorCount, dev);
        hipOccupancyMaxActiveBlocksPerMultiprocessor(&per_cu, fwd_megakernel, NTHREADS, 0);
        if (per_cu > 2) per_cu = 2;
        if (per_cu < 1) per_cu = 1;
        grid_blocks = cus * per_cu;
    }
    hipMemsetAsync(p.bar, 0, XCD_BAR_WORDS * 4, stream);
    void* args[] = {&p};
    hipError_t e = hipLaunchCooperativeKernel((void*)fwd_megakernel, dim3(grid_blocks), dim3(NTHREADS), args, 0, stream);
    if (e != hipSuccess) fprintf(stderr, "cooperative launch failed: %s (grid %d)\n", hipGetErrorString(e), grid_blocks);
#endif
}
```

```cpp
#include <hip/hip_runtime.h>
#include <hip/hip_cooperative_groups.h>
#include <cstdio>
#include <cstdint>
namespace cg = cooperative_groups;

#ifndef REP1
#define REP1 1
#endif
#ifndef REP3
#define REP3 1
#endif
#ifndef REP5
#define REP5 1
#endif
#ifndef REP0
#define REP0 1
#endif
#ifndef MULTI_LAUNCH
#define MULTI_LAUNCH 0
#endif

typedef unsigned short u16;
typedef short bf16x8 __attribute__((ext_vector_type(8)));
typedef float f32x4 __attribute__((ext_vector_type(4)));
typedef float f32x2 __attribute__((ext_vector_type(2)));
typedef float f32x16 __attribute__((ext_vector_type(16)));
typedef unsigned u32x4 __attribute__((ext_vector_type(4)));
typedef unsigned u32x2 __attribute__((ext_vector_type(2)));
typedef __bf16 bf16x2_t __attribute__((ext_vector_type(2)));

#define DI __device__ __forceinline__
#define MFMA32(a, b, c) __builtin_amdgcn_mfma_f32_32x32x16_bf16((a), (b), (c), 0, 0, 0)

constexpr int D = 1024, TP = 32768, TS = 2048, T = TP + TS, PAST = 1024, SKL = 1088;
constexpr int NTHREADS = 256;
constexpr int LDS_BYTES = 73728 + 64;
constexpr float EPS = 1e-6f;
constexpr float QSCALE = 0.125f * 1.4426950408889634f;
constexpr size_t O_Y = 0, O_SP = 35651584, O_SS = 35782656, O_KP = 36831232, O_VP = 53608448, O_KS = 70385664, O_VS = 71434240;
constexpr size_t TR_S_OFF = 16777216;
constexpr int NITEMS = 32 + 2048 + 128 + 256;

struct Params {
    const float *x_p, *x_s, *cache_k, *cache_v, *state_ret, *norm_g, *w_in, *w_out, *ret_norm_g, *diff_norm_g, *lam_q1, *lam_k1, *lam_q2, *lam_k2, *final_g;
    float* out;
    u16 *H, *WtIn, *WtOut, *RQ, *RK, *RKtd, *RVt, *RG, *DQ, *DKp, *SK, *DVtp, *SVt, *DG, *MIX, *SPREV;
    float *cosR, *sinR, *cosD, *sinD, *misc, *rowss;
    unsigned* ctr; unsigned* bar; unsigned* done;
    int never; int pad_;
};

DI unsigned pk2(float lo, float hi) { f32x2 v = {lo, hi}; bf16x2_t b = __builtin_convertvector(v, bf16x2_t); return __builtin_bit_cast(unsigned, b); }
DI u16 f2bf(float x) { return (u16)(pk2(x, 0.f) & 0xffffu); }
DI float bf2f(unsigned v) { return __uint_as_float(v << 16); }
DI int crow(int i, int h) { return (i & 3) + 8 * (i >> 2) + 4 * h; }
DI float silu(float v) { return v / (1.f + __expf(-v)); }
DI float log2_gamma(int hd) {
    const float x = exp2f(-5.f - (float)hd);
    float s = x * (1.f + x * (0.5f + x * (1.f / 3.f + x * (0.25f + x * (0.2f + x * (1.f / 6.f))))));
    return -s * 1.4426950408889634f;
}
template <int S> DI bf16x8 pack8(const f32x16& x) {
    u32x4 p;
    p.x = pk2(x[8 * S + 0], x[8 * S + 1]); p.y = pk2(x[8 * S + 2], x[8 * S + 3]);
    p.z = pk2(x[8 * S + 4], x[8 * S + 5]); p.w = pk2(x[8 * S + 6], x[8 * S + 7]);
    return __builtin_bit_cast(bf16x8, p);
}
DI float xhalf_max(float v) { auto r = __builtin_amdgcn_permlane32_swap(__float_as_uint(v), __float_as_uint(v), false, false); return fmaxf(__uint_as_float(r[0]), __uint_as_float(r[1])); }
DI float xhalf_sum(float v) { auto r = __builtin_amdgcn_permlane32_swap(__float_as_uint(v), __float_as_uint(v), false, false); return __uint_as_float(r[0]) + __uint_as_float(r[1]); }
DI f32x16 zero16() { f32x16 z; for (int i = 0; i < 16; ++i) z[i] = 0.f; return z; }


#define XB_TMO      128
#define XB_XCNT(j)  (256  + 64 * (j))
#define XB_XSUB(j)  (1280 + 64 * (j))
#define XB_XGEN(j)  (2304 + 64 * (j))
#define XB_TOP      3328
#define XB_TOPGEN   3392
#define XCD_BAR_WORDS 3456
#define XB_SPIN_CAP (1u << 20)
#define LAS __attribute__((address_space(3)))
DI unsigned xb_ld(unsigned* p)              { return __hip_atomic_load(p, __ATOMIC_RELAXED, __HIP_MEMORY_SCOPE_AGENT); }
DI unsigned xb_add(unsigned* p, unsigned v) { return __hip_atomic_fetch_add(p, v, __ATOMIC_RELAXED, __HIP_MEMORY_SCOPE_AGENT); }
DI unsigned xb_xcc_id() { return (unsigned)__builtin_amdgcn_s_getreg((3 << 11) | 20) & 0xFu; }
#define XB_SPIN(cond, bar) do { unsigned _sp = 0; while (cond) { __builtin_amdgcn_s_sleep(1); \
    if ((++_sp & 255u) == 0u) { if (xb_ld(&(bar)[XB_TMO])) break; if (_sp > XB_SPIN_CAP) { atomicAdd(&(bar)[XB_TMO], 1u); break; } } } } while (0)
struct XcdBarrier { unsigned* bar; unsigned x; volatile LAS unsigned* st; };
DI XcdBarrier xcd_barrier_post(unsigned* bar, volatile LAS unsigned* st) {
    XcdBarrier b; b.bar = bar; b.x = xb_xcc_id(); b.st = st;
    if (threadIdx.x == 0) (void)xb_add(&bar[XB_XCNT(b.x)], 1u);
    return b;
}
DI void xcd_barrier_complete(unsigned* bar, unsigned x, unsigned& nloc, unsigned& nx) {
    const unsigned G = gridDim.x * gridDim.y * gridDim.z;
    unsigned sum, cnt, mine, sp = 0u;
    for (;;) {
        sum = 0u; cnt = 0u; mine = 0u;
#pragma unroll
        for (unsigned j = 0; j < 16; ++j) { const unsigned c = xb_ld(&bar[XB_XCNT(j)]); sum += c; cnt += (c > 0u) ? 1u : 0u; mine = (j == x) ? c : mine; }
        if (sum == G) break;
        __builtin_amdgcn_s_sleep(1);
        if ((++sp & 255u) == 0u) { if (xb_ld(&bar[XB_TMO])) break; if (sp > XB_SPIN_CAP) { atomicAdd(&bar[XB_TMO], 1u); break; } }
    }
    nloc = mine > 0u ? mine : 1u; nx = cnt > 0u ? cnt : 1u;
}
DI void xcd_barrier(const XcdBarrier& b) {
    asm volatile("s_waitcnt vmcnt(0)" ::: "memory");
    __syncthreads();
    if (threadIdx.x == 0) {
        unsigned* bar = b.bar;
        __builtin_amdgcn_s_waitcnt(0);
        unsigned nloc = b.st[0], nx = b.st[1];
        if (nloc == 0u) { xcd_barrier_complete(bar, b.x, nloc, nx); b.st[0] = nloc; b.st[1] = nx; }
        const unsigned old = xb_add(&bar[XB_XSUB(b.x)], 1u);
        const unsigned gen = old / nloc;
        if (old + 1u == (gen + 1u) * nloc) {
            __builtin_amdgcn_fence(__ATOMIC_RELEASE, "agent");
            asm volatile("s_waitcnt vmcnt(0)" ::: "memory");
            const unsigned og = xb_add(&bar[XB_TOP], 1u);
            const unsigned tg = og / nx;
            if (og + 1u == (tg + 1u) * nx) xb_add(&bar[XB_TOPGEN], 1u);
            else XB_SPIN(xb_ld(&bar[XB_TOPGEN]) == tg, bar);
            __builtin_amdgcn_fence(__ATOMIC_ACQUIRE, "agent");
            xb_add(&bar[XB_XGEN(b.x)], 1u);
            asm volatile("s_waitcnt vmcnt(0)" ::: "memory");
        } else {
            XB_SPIN(xb_ld(&bar[XB_XGEN(b.x)]) == gen, bar);
            __builtin_amdgcn_fence(__ATOMIC_ACQUIRE, "agent");
            asm volatile("s_waitcnt vmcnt(0)" ::: "memory");
        }
    }
    __syncthreads();
}

struct TJob { const float* src; size_t ss; u16* dst; size_t ds; bool perm; };
DI TJob tjob(const Params& p, int t) {
    TJob j;
    if (t < 1024) { const int kt = t >> 6, nt = t & 63;
        j.src = p.w_in + (size_t)kt * 64 * 4096 + nt * 64; j.ss = 4096; j.dst = p.WtIn + (size_t)nt * 64 * 1024 + kt * 64; j.ds = 1024; j.perm = false;
    } else if (t < 1280) { const int q = t - 1024, kt = q >> 4, nt = q & 15;
        j.src = p.w_out + (size_t)kt * 64 * 1024 + nt * 64; j.ss = 1024; j.dst = p.WtOut + (size_t)nt * 64 * 1024 + kt * 64; j.ds = 1024; j.perm = false;
    } else { const int q = t - 1280, sbh = q >> 5, keyt = (q >> 1) & 15, dvt = q & 1, sb = sbh >> 2, hh = sbh & 3;
        j.src = p.cache_v + ((size_t)sb * 1024 + keyt * 64) * 512 + hh * 128 + dvt * 64; j.ss = 512; j.dst = p.SVt + ((size_t)sbh * 17 + keyt) * 8192 + dvt * 64 * 64; j.ds = 64; j.perm = true;
    }
    return j;
}
DI void tr_load(const TJob& j, f32x4 (&v)[4], int tid) {
#pragma unroll
    for (int i = 0; i < 4; ++i) v[i] = __builtin_nontemporal_load((const f32x4*)(j.src + (size_t)((tid >> 4) + 16 * i) * j.ss + (tid & 15) * 4));
}
DI void tr_put(const f32x4 (&v)[4], float* tile, int tid) {
#pragma unroll
    for (int i = 0; i < 4; ++i) { const int r = (tid >> 4) + 16 * i, c4 = (tid & 15) * 4;
        tile[(c4 + 0) * 65 + r] = v[i].x; tile[(c4 + 1) * 65 + r] = v[i].y; tile[(c4 + 2) * 65 + r] = v[i].z; tile[(c4 + 3) * 65 + r] = v[i].w; }
}
DI void tr_store(const TJob& j, const float* tile, int tid) {
#pragma unroll
    for (int i = 0; i < 2; ++i) {
        const int id = tid + 256 * i, c = id >> 3, p0 = (id & 7) * 8;
        float e[8];
#pragma unroll
        for (int jj = 0; jj < 8; ++jj) { const int pos = p0 + jj; const int r = j.perm ? ((pos & ~12) | ((pos & 4) << 1) | ((pos & 8) >> 1)) : pos; e[jj] = tile[c * 65 + r]; }
        u32x4 w; w.x = pk2(e[0], e[1]); w.y = pk2(e[2], e[3]); w.z = pk2(e[4], e[5]); w.w = pk2(e[6], e[7]);
        *(u32x4*)(j.dst + (size_t)c * j.ds + p0) = w;
    }
}

__device__ void p0_prep(const Params& p, unsigned char* smem) {
    int tid = threadIdx.x; asm volatile("" : "+v"(tid)); const int lane = tid & 63, wid = tid >> 6, nb = gridDim.x, bid = blockIdx.x;
    if (bid == 0 && tid == 0) {
        float s1 = 0.f, s2 = 0.f;
        for (int i = 0; i < 64; ++i) { s1 += p.lam_q1[i] * p.lam_k1[i]; s2 += p.lam_q2[i] * p.lam_k2[i]; }
        p.misc[0] = expf(s1) - expf(s2) + 0.2f;
        for (int i = 0; i < 288; ++i) p.ctr[i] = 0u;
        for (int i = 0; i < 128; ++i) p.done[i] = 0u;
    }
    for (int i = bid * 256 + tid; i < T; i += nb * 256) p.rowss[i] = 0.f;
    for (int row = (bid * 4 + wid) * 2; row < T; row += nb * 8) {
        f32x4 v[2][4]; float ss[2] = {0.f, 0.f};
#pragma unroll
        for (int q = 0; q < 2; ++q) { const int rw = row + q; const float* src = rw < TP ? p.x_p + (size_t)rw * D : p.x_s + (size_t)(rw - TP) * D;
#pragma unroll
            for (int i = 0; i < 4; ++i) v[q][i] = __builtin_nontemporal_load((const f32x4*)(src + (lane + 64 * i) * 4)); }
        f32x4 g[4];
#pragma unroll
        for (int i = 0; i < 4; ++i) g[i] = *(const f32x4*)(p.norm_g + (lane + 64 * i) * 4);
#pragma unroll
        for (int q = 0; q < 2; ++q) {
#pragma unroll
            for (int i = 0; i < 4; ++i) ss[q] += v[q][i].x * v[q][i].x + v[q][i].y * v[q][i].y + v[q][i].z * v[q][i].z + v[q][i].w * v[q][i].w;
#pragma unroll
            for (int o = 32; o >= 1; o >>= 1) ss[q] += __shfl_xor(ss[q], o);
            const float rstd = rsqrtf(ss[q] * (1.f / 1024.f) + EPS);
#pragma unroll
            for (int i = 0; i < 4; ++i) {
                u32x2 w; w.x = pk2(v[q][i].x * rstd * g[i].x, v[q][i].y * rstd * g[i].y); w.y = pk2(v[q][i].z * rstd * g[i].z, v[q][i].w * rstd * g[i].w);
                *(u32x2*)(p.H + (size_t)(row + q) * D + (lane + 64 * i) * 4) = w;
            }
        }
    }
    float* tile0 = (float*)smem; float* tile1 = tile0 + 64 * 65;
    for (int t = bid; t < 1280; t += 2 * nb) {
        const bool two = t + nb < 1280;
        const TJob j0 = tjob(p, t), j1 = tjob(p, two ? t + nb : t);
        f32x4 v0[4], v1[4];
        tr_load(j0, v0, tid); if (two) tr_load(j1, v1, tid);
        __syncthreads();
        tr_put(v0, tile0, tid); if (two) tr_put(v1, tile1, tid);
        __syncthreads();
        tr_store(j0, tile0, tid); if (two) tr_store(j1, tile1, tid);
    }
    for (int i = bid * 256 + tid; i < 8192 * 40; i += nb * 256) {
        const int pos = i / 40, f = i % 40;
        const float inv = f < 32 ? exp2f(-13.287712379549449f * (float)f * (1.f / 32.f)) : exp2f(-18.931568569324174f * (float)(f - 32) * (1.f / 8.f));
        const float ang = (float)pos * inv;
        const double rev = (double)ang * 0.15915494309189535; const float fr = (float)(rev - rint(rev));
        const float sn = __builtin_amdgcn_sinf(fr), cs = __builtin_amdgcn_cosf(fr);
        if (f < 32) { p.cosR[pos * 32 + f] = cs; p.sinR[pos * 32 + f] = sn; } else { p.cosD[pos * 8 + f - 32] = cs; p.sinD[pos * 8 + f - 32] = sn; }
    }
}

DI void stage_store(float* stg, const float (&v0)[16], const float (&v1)[16], u16* base, size_t ld, int lane, bool nt = true) {
    const int r = lane & 31, h = lane >> 5;
#pragma unroll
    for (int i = 0; i < 16; ++i) { stg[crow(i, h) * 68 + r] = v0[i]; stg[crow(i, h) * 68 + 32 + r] = v1[i]; }
    __builtin_amdgcn_wave_barrier();
#pragma unroll
    for (int j = 0; j < 4; ++j) {
        const int row = (lane >> 3) + 8 * j, ch = lane & 7;
        const f32x4 x = *(const f32x4*)(stg + row * 68 + ch * 8), y = *(const f32x4*)(stg + row * 68 + ch * 8 + 4);
        u32x4 w; w.x = pk2(x.x, x.y); w.y = pk2(x.z, x.w); w.z = pk2(y.x, y.y); w.w = pk2(y.z, y.w);
        if (nt) __builtin_nontemporal_store(w, (u32x4*)(base + (size_t)row * ld + ch * 8));
        else *(u32x4*)(base + (size_t)row * ld + ch * 8) = w;
    }
    __builtin_amdgcn_wave_barrier();
}
DI void store_tr(u16* tb, const float (&v0)[16], const float (&v1)[16], int r, int h, bool nt = true) {
#pragma unroll
    for (int G = 0; G < 2; ++G) {
        u32x4 w0, w1;
        w0.x = pk2(v0[8 * G + 0], v0[8 * G + 1]); w0.y = pk2(v0[8 * G + 2], v0[8 * G + 3]); w0.z = pk2(v0[8 * G + 4], v0[8 * G + 5]); w0.w = pk2(v0[8 * G + 6], v0[8 * G + 7]);
        w1.x = pk2(v1[8 * G + 0], v1[8 * G + 1]); w1.y = pk2(v1[8 * G + 2], v1[8 * G + 3]); w1.z = pk2(v1[8 * G + 4], v1[8 * G + 5]); w1.w = pk2(v1[8 * G + 6], v1[8 * G + 7]);
        if (nt) { __builtin_nontemporal_store(w0, (u32x4*)(tb + (size_t)r * 64 + 16 * G + 8 * h)); __builtin_nontemporal_store(w1, (u32x4*)(tb + (size_t)(32 + r) * 64 + 16 * G + 8 * h)); }
        else { *(u32x4*)(tb + (size_t)r * 64 + 16 * G + 8 * h) = w0; *(u32x4*)(tb + (size_t)(32 + r) * 64 + 16 * G + 8 * h) = w1; }
    }
}
template <int MI> DI void p1_epilogue(const Params& p, const f32x16 (&acc)[MI][2], int mt, int nt, int wm, int wn, int lane, float* stg) {
    const int r = lane & 31, h = lane >> 5;
    const int seg = nt >> 2;
    const int cseg0 = (nt & 3) * 128 + wn * 64;
#pragma unroll
    for (int mi = 0; mi < MI; ++mi) {
        const int tok0 = mt * (64 * MI) + wm * (32 * MI) + mi * 32;
        const bool samp = tok0 >= TP;
        int bseq, t0;
        if (!samp) { bseq = tok0 >> 13; t0 = tok0 & 8191; } else { const int st = tok0 - TP; bseq = st >> 6; t0 = st & 63; }
        const int pos0 = samp ? PAST + t0 : t0;
        float v0[16], v1[16];
        if (seg == 0 || seg == 1) {
            const int head = cseg0 >> 6;
            const float sc = seg == 0 ? 1.f : 0.125f;
            {
                const int pb = pos0 + 4 * h;
                float cg = p.cosR[pb * 32 + r], sg = p.sinR[pb * 32 + r];
                const float c1 = p.cosR[32 + r], s1 = p.sinR[32 + r], c8 = p.cosR[256 + r], s8 = p.sinR[256 + r];
#pragma unroll
                for (int g = 0; g < 4; ++g) {
                    float c = cg, s = sg;
#pragma unroll
                    for (int b = 0; b < 4; ++b) {
                        const int i = 4 * g + b;
                        const float a0 = acc[mi][0][i], a1 = acc[mi][1][i];
                        v0[i] = (a0 * c - a1 * s) * sc; v1[i] = (a1 * c + a0 * s) * sc;
                        const float cn = c * c1 - s * s1, sn = s * c1 + c * s1; c = cn; s = sn;
                    }
                    const float cn = cg * c8 - sg * s8, sn = sg * c8 + cg * s8; cg = cn; sg = sn;
                }
            }
            stage_store(stg, v0, v1, (seg == 0 ? p.RQ : p.RK) + (size_t)tok0 * 512 + cseg0, 512, lane);
            if (seg == 1) {
                const float lg = log2_gamma(head);
                u16* tb = (samp ? p.RKtd + TR_S_OFF + (size_t)(bseq * 8 + head) * 4096 : p.RKtd + ((size_t)(bseq * 8 + head) * 128 + (t0 >> 6)) * 4096) + (t0 & 63);
#pragma unroll
                for (int i = 0; i < 16; ++i) { const float dc = __builtin_amdgcn_exp2f(lg * (float)(63 - ((t0 + crow(i, h)) & 63))); v0[i] *= dc; v1[i] *= dc; }
                store_tr(tb, v0, v1, r, h);
            }
        } else if (seg == 2) {
            const int head = cseg0 >> 6;
            u16* tb = (samp ? p.RVt + TR_S_OFF + (size_t)(bseq * 8 + head) * 4096 : p.RVt + ((size_t)(bseq * 8 + head) * 128 + (t0 >> 6)) * 4096) + (t0 & 63);
#pragma unroll
            for (int i = 0; i < 16; ++i) { v0[i] = acc[mi][0][i]; v1[i] = acc[mi][1][i]; }
            store_tr(tb, v0, v1, r, h);
        } else if (seg == 3 || seg == 7) {
#pragma unroll
            for (int i = 0; i < 16; ++i) { v0[i] = silu(acc[mi][0][i]); v1[i] = silu(acc[mi][1][i]); }
            stage_store(stg, v0, v1, (seg == 3 ? p.RG : p.DG) + (size_t)tok0 * 512 + cseg0, 512, lane);
        } else if (seg == 4 || seg == 5) {
            {
                const int pb = pos0 + 4 * h, f = r & 7;
                float cg = p.cosD[pb * 8 + f], sg = p.sinD[pb * 8 + f];
                const float c1 = p.cosD[8 + f], s1 = p.sinD[8 + f], c8 = p.cosD[64 + f], s8 = p.sinD[64 + f];
#pragma unroll
                for (int g = 0; g < 4; ++g) {
                    float c = cg, s = sg;
#pragma unroll
                    for (int b = 0; b < 4; ++b) {
                        const int i = 4 * g + b;
                        const float v = acc[mi][0][i], pr = __shfl_xor(v, 8);
                        v0[i] = r < 8 ? v * c - pr * s : (r < 16 ? v * c + pr * s : v); v1[i] = acc[mi][1][i];
                        const float cn = c * c1 - s * s1, sn = s * c1 + c * s1; c = cn; s = sn;
                    }
                    const float cn = cg * c8 - sg * s8, sn = sg * c8 + cg * s8; cg = cn; sg = sn;
                }
            }
            if (seg == 4) {
#pragma unroll
                for (int i = 0; i < 16; ++i) { v0[i] *= QSCALE; v1[i] *= QSCALE; }
                stage_store(stg, v0, v1, p.DQ + (size_t)tok0 * 512 + cseg0, 512, lane);
            } else {
                float* ko = (samp ? p.out + O_KS + (size_t)(tok0 - TP) * 512 : p.out + O_KP + (size_t)tok0 * 512) + cseg0 + r;
                const int head4 = cseg0 >> 7, colh = cseg0 & 127;
                u16* kb = (samp ? p.SK + ((size_t)(bseq * 4 + head4) * 17 + 16) * 8192 : p.DKp + ((size_t)(bseq * 4 + head4) * 128 + (t0 >> 6)) * 8192) + (t0 & 63) * 128 + colh;
#pragma unroll
                for (int i = 0; i < 16; ++i) { const size_t ro = (size_t)crow(i, h) * 512; __builtin_nontemporal_store(v0[i], ko + ro); __builtin_nontemporal_store(v1[i], ko + ro + 32); }
                stage_store(stg, v0, v1, kb, 128, lane, false);
            }
        } else {
            float* vo = (samp ? p.out + O_VS + (size_t)(tok0 - TP) * 512 : p.out + O_VP + (size_t)tok0 * 512) + cseg0 + r;
            const int head4 = cseg0 >> 7, dv0 = cseg0 & 127;
            u16* tb = (samp ? p.SVt + ((size_t)(bseq * 4 + head4) * 17 + 16) * 8192 : p.DVtp + ((size_t)(bseq * 4 + head4) * 128 + (t0 >> 6)) * 8192) + dv0 * 64 + (t0 & 63);
#pragma unroll
            for (int i = 0; i < 16; ++i) { v0[i] = acc[mi][0][i]; v1[i] = acc[mi][1][i]; const size_t ro = (size_t)crow(i, h) * 512; __builtin_nontemporal_store(v0[i], vo + ro); __builtin_nontemporal_store(v1[i], vo + ro + 32); }
            store_tr(tb, v0, v1, r, h, false);
        }
    }
}

template <int MI> DI void gemm_core(const u16* __restrict__ Ag, const u16* __restrict__ Bg, u16* smem16, f32x16 (&acc)[MI][2], int tid) {
    constexpr int AST = 64 * MI * 40, STAGE = AST + 128 * 40;
    const int lane = tid & 63, wid = tid >> 6, r = lane & 31, h = lane >> 5, wm = wid >> 1, wn = wid & 1, lrow = tid >> 2, lch = tid & 3;
    const u16* ag = Ag + (size_t)lrow * 1024 + lch * 8; const u16* bg = Bg + (size_t)lrow * 1024 + lch * 8;
    const int wofs = lrow * 40 + lch * 8;
    const int afo = (32 * MI * wm + r) * 40 + 8 * h, bfo = AST + (64 * wn + r) * 40 + 8 * h;
#pragma unroll
    for (int a = 0; a < MI; ++a) { acc[a][0] = zero16(); acc[a][1] = zero16(); }
    u32x4 ra[MI], rb[2];
#pragma unroll
    for (int i = 0; i < MI; ++i) ra[i] = *(const u32x4*)(ag + (size_t)i * 64 * 1024);
#pragma unroll
    for (int i = 0; i < 2; ++i) rb[i] = *(const u32x4*)(bg + (size_t)i * 64 * 1024);
    __syncthreads();
#pragma unroll
    for (int i = 0; i < MI; ++i) *(u32x4*)(smem16 + wofs + i * 64 * 40) = ra[i];
#pragma unroll
    for (int i = 0; i < 2; ++i) *(u32x4*)(smem16 + AST + wofs + i * 64 * 40) = rb[i];
#pragma unroll
    for (int i = 0; i < MI; ++i) ra[i] = *(const u32x4*)(ag + (size_t)i * 64 * 1024 + 32);
#pragma unroll
    for (int i = 0; i < 2; ++i) rb[i] = *(const u32x4*)(bg + (size_t)i * 64 * 1024 + 32);
    __syncthreads();
    for (int kt = 0; kt < 32; ++kt) {
        const u16* cur = smem16 + (kt & 1) * STAGE;
        u16* nxt = smem16 + ((kt & 1) ^ 1) * STAGE;
        bf16x8 a0[MI], b0[2], a1[MI], b1[2];
#pragma unroll
        for (int mi = 0; mi < MI; ++mi) a0[mi] = *(const bf16x8*)(cur + afo + mi * 32 * 40);
#pragma unroll
        for (int ni = 0; ni < 2; ++ni) b0[ni] = *(const bf16x8*)(cur + bfo + ni * 32 * 40);
        __builtin_amdgcn_sched_barrier(0);
        if (kt < 31) {
#pragma unroll
            for (int i = 0; i < MI; ++i) *(u32x4*)(nxt + wofs + i * 64 * 40) = ra[i];
#pragma unroll
            for (int i = 0; i < 2; ++i) *(u32x4*)(nxt + AST + wofs + i * 64 * 40) = rb[i];
            if (kt < 30) {
#pragma unroll
                for (int i = 0; i < MI; ++i) ra[i] = *(const u32x4*)(ag + (size_t)i * 64 * 1024 + (kt + 2) * 32);
#pragma unroll
                for (int i = 0; i < 2; ++i) rb[i] = *(const u32x4*)(bg + (size_t)i * 64 * 1024 + (kt + 2) * 32);
            }
        }
#pragma unroll
        for (int mi = 0; mi < MI; ++mi) a1[mi] = *(const bf16x8*)(cur + afo + mi * 32 * 40 + 16);
#pragma unroll
        for (int ni = 0; ni < 2; ++ni) b1[ni] = *(const bf16x8*)(cur + bfo + ni * 32 * 40 + 16);
        __builtin_amdgcn_sched_barrier(0);
#pragma unroll
        for (int mi = 0; mi < MI; ++mi) { acc[mi][0] = MFMA32(a0[mi], b0[0], acc[mi][0]); acc[mi][1] = MFMA32(a0[mi], b0[1], acc[mi][1]); }
#pragma unroll
        for (int mi = 0; mi < MI; ++mi) { acc[mi][0] = MFMA32(a1[mi], b1[0], acc[mi][0]); acc[mi][1] = MFMA32(a1[mi], b1[1], acc[mi][1]); }
        __syncthreads();
    }
}

__device__ void p1_gemm(const Params& p, unsigned char* smem) {
    for (int tile_ = blockIdx.x; tile_ < 136 * 32 * REP1; tile_ += gridDim.x) {
        int tid = threadIdx.x; asm volatile("" : "+v"(tid));
        const int tile = tile_ % (136 * 32);
        int mt = tile >> 5, nt = tile & 31;
        if (tile < 4096 && (gridDim.x & 511) == 0) {
            const int rnd = tile >> 9, b = tile & 511, x = b & 7, idx = b >> 3;
            mt = rnd * 16 + 4 * (x >> 1) + (idx >> 4); nt = 16 * (x & 1) + (idx & 15);
        }
        f32x16 acc[4][2];
        gemm_core<4>(p.H + (size_t)mt * 256 * 1024, p.WtIn + (size_t)nt * 128 * 1024, (u16*)smem, acc, tid);
        __syncthreads();
        p1_epilogue<4>(p, acc, mt, nt, (tid >> 6) >> 1, (tid >> 6) & 1, tid & 63, (float*)smem + (tid >> 6) * (32 * 68));
    }
    {
        int tid = threadIdx.x; asm volatile("" : "+v"(tid));
        int* s_item = (int*)(smem + 73728);
        float* tile0 = (float*)smem; float* tile1 = tile0 + 64 * 65;
        for (;;) {
            __syncthreads();
            if (tid == 0) *s_item = (int)atomicAdd(p.ctr + 8 * 32, 1u);
            __syncthreads();
            const int j = __builtin_amdgcn_readfirstlane(*s_item);
            if (j >= 4096) break;
            if (j < 2048) {
                const TJob j0 = tjob(p, 1280 + 2 * j), j1 = tjob(p, 1280 + 2 * j + 1);
                f32x4 v0[4], v1[4];
                tr_load(j0, v0, tid); tr_load(j1, v1, tid);
                tr_put(v0, tile0, tid); tr_put(v1, tile1, tid);
                __syncthreads();
                tr_store(j0, tile0, tid); tr_store(j1, tile1, tid);
            } else {
                const size_t base = (size_t)(j - 2048) * 2048;
                f32x4 v[8];
#pragma unroll
                for (int q = 0; q < 8; ++q) v[q] = __builtin_nontemporal_load((const f32x4*)(p.cache_k + (base + tid + 256 * q) * 4));
#pragma unroll
                for (int q = 0; q < 8; ++q) {
                    const size_t i = base + tid + 256 * q, row = i >> 7; const int c4 = (int)(i & 127), sb = (int)(row >> 10), t = (int)(row & 1023);
                    u32x2 w; w.x = pk2(v[q].x, v[q].y); w.y = pk2(v[q].z, v[q].w);
                    *(u32x2*)(p.SK + ((size_t)(sb * 4 + (c4 >> 5)) * 17 + (t >> 6)) * 8192 + (t & 63) * 128 + (c4 & 31) * 4) = w;
                }
            }
        }
    }
}

constexpr int KV_STAGE = 2 * 128 * 72;
__device__ void attn_unit(const Params& p, unsigned char* smem, const u16* __restrict__ qptr, const u16* __restrict__ kptr, const u16* __restrict__ vtptr,
                          int ntiles, int tok0, int head) {
    u16* sKV = (u16*)smem;
    int tid = threadIdx.x; asm volatile("" : "+v"(tid)); const int lane = tid & 63, wid = tid >> 6, r = lane & 31, h = lane >> 5, c = wid & 1, rg = wid >> 1;
    bf16x8 qf[4];
#pragma unroll
    for (int ks = 0; ks < 4; ++ks) qf[ks] = *(const bf16x8*)(qptr + (size_t)(32 * rg + r) * 512 + c * 64 + 16 * ks + 8 * h);
    f32x16 O[4];
#pragma unroll
    for (int i = 0; i < 4; ++i) O[i] = zero16();
    float m = -1e30f, l = 0.f;
    const int kkey = tid >> 4, kcc = tid & 15;
    const int vdv = tid >> 3, vch = tid & 7;
    const u16* kg = kptr + tid * 8;
    const u16* vg = vtptr + tid * 8;
    const int klo = ((kcc >> 3) * 64 + kkey) * 72 + (kcc & 7) * 8;
    const int vlo = 128 * 72 + vdv * 72 + vch * 8;
    const int kfo = (c * 64 + r) * 72 + 8 * h;
    const int vfo = 128 * 72 + r * 72 + 8 * h;
    u32x4 rk[4], rv[4];
#pragma unroll
    for (int i = 0; i < 4; ++i) { rk[i] = *(const u32x4*)(kg + i * 2048); rv[i] = *(const u32x4*)(vg + i * 2048); }
    __syncthreads();
#pragma unroll
    for (int i = 0; i < 4; ++i) { *(u32x4*)(sKV + klo + i * 16 * 72) = rk[i]; *(u32x4*)(sKV + vlo + i * 32 * 72) = rv[i]; }
    if (ntiles > 1) {
#pragma unroll
        for (int i = 0; i < 4; ++i) { rk[i] = *(const u32x4*)(kg + 8192 + i * 2048); rv[i] = *(const u32x4*)(vg + 8192 + i * 2048); }
    }
    __syncthreads();
    for (int kt = 0; kt < ntiles; ++kt) {
        const u16* cur = sKV + (kt & 1) * KV_STAGE;
        u16* nxt = sKV + ((kt & 1) ^ 1) * KV_STAGE;
        bf16x8 kf[2][4];
#pragma unroll
        for (int ks = 0; ks < 4; ++ks) { kf[0][ks] = *(const bf16x8*)(cur + kfo + 16 * ks); kf[1][ks] = *(const bf16x8*)(cur + kfo + 32 * 72 + 16 * ks); }
        __builtin_amdgcn_sched_barrier(0);
        f32x16 S0 = zero16(), S1 = zero16();
#pragma unroll
        for (int ks = 0; ks < 4; ++ks) { S0 = MFMA32(kf[0][ks], qf[ks], S0); S1 = MFMA32(kf[1][ks], qf[ks], S1); __builtin_amdgcn_sched_barrier(0); }
        bf16x8 va[4][2];
#pragma unroll
        for (int d = 0; d < 4; ++d)
#pragma unroll
            for (int q = 0; q < 2; ++q) va[d][q] = *(const bf16x8*)(cur + vfo + d * 32 * 72 + 16 * q);
        if (kt + 1 < ntiles) {
#pragma unroll
            for (int i = 0; i < 4; ++i) { *(u32x4*)(nxt + klo + i * 16 * 72) = rk[i]; *(u32x4*)(nxt + vlo + i * 32 * 72) = rv[i]; }
            if (kt + 2 < ntiles) {
#pragma unroll
                for (int i = 0; i < 4; ++i) { rk[i] = *(const u32x4*)(kg + (size_t)(kt + 2) * 8192 + i * 2048); rv[i] = *(const u32x4*)(vg + (size_t)(kt + 2) * 8192 + i * 2048); }
            }
        }
        __builtin_amdgcn_sched_barrier(0);
        float mt = fmaxf(S0[0], S1[0]);
#pragma unroll
        for (int i = 1; i < 16; ++i) mt = fmaxf(mt, fmaxf(S0[i], S1[i]));
        mt = xhalf_max(mt);
        if (__any(mt > m)) {
            const float mn = fmaxf(m, mt), al = __builtin_amdgcn_exp2f(m - mn);
            m = mn; l *= al;
#pragma unroll
            for (int d = 0; d < 4; ++d)
#pragma unroll
                for (int i = 0; i < 16; ++i) O[d][i] *= al;
        }
        const f32x2 m2 = {m, m};
        f32x2 l2 = {0.f, 0.f};
        u32x4 pw[4];
#pragma unroll
        for (int j = 0; j < 8; ++j) {
            f32x2 x0 = {S0[2 * j], S0[2 * j + 1]};
            x0 = x0 - m2;
            f32x2 e0; e0.x = __builtin_amdgcn_exp2f(x0.x); e0.y = __builtin_amdgcn_exp2f(x0.y);
            l2 = l2 + e0;
            pw[j >> 2][j & 3] = pk2(e0.x, e0.y);
        }
        const bf16x8 p00 = __builtin_bit_cast(bf16x8, pw[0]), p01 = __builtin_bit_cast(bf16x8, pw[1]);
        bf16x8 vb[4][2];
#pragma unroll
        for (int d = 0; d < 4; ++d)
#pragma unroll
            for (int q = 0; q < 2; ++q) vb[d][q] = *(const bf16x8*)(cur + vfo + d * 32 * 72 + 32 + 16 * q);
#pragma unroll
        for (int j = 0; j < 8; ++j) {
            O[j & 3] = MFMA32(va[j & 3][j >> 2], (j >> 2) ? p01 : p00, O[j & 3]);
            f32x2 x1 = {S1[2 * j], S1[2 * j + 1]};
            x1 = x1 - m2;
            f32x2 e1; e1.x = __builtin_amdgcn_exp2f(x1.x); e1.y = __builtin_amdgcn_exp2f(x1.y);
            l2 = l2 + e1;
            pw[2 + (j >> 2)][j & 3] = pk2(e1.x, e1.y);
        }
        l += l2.x + l2.y;
        const bf16x8 p10 = __builtin_bit_cast(bf16x8, pw[2]), p11 = __builtin_bit_cast(bf16x8, pw[3]);
#pragma unroll
        for (int j = 0; j < 8; ++j) O[j & 3] = MFMA32(vb[j & 3][j >> 2], (j >> 2) ? p11 : p10, O[j & 3]);
        __syncthreads();
    }
    const float inv = 1.f / xhalf_sum(l);
    const float lam = p.misc[0];
    float* ex = (float*)smem + rg * 4096;
    if (c == 1) {
        const float sc = inv * lam;
#pragma unroll
        for (int d = 0; d < 4; ++d)
#pragma unroll
            for (int i = 0; i < 16; ++i) ex[(d * 16 + i) * 64 + lane] = O[d][i] * sc;
    }
    __syncthreads();
    if (c == 0) {
        float ss = 0.f;
#pragma unroll
        for (int d = 0; d < 4; ++d)
#pragma unroll
            for (int i = 0; i < 16; ++i) { const float v = O[d][i] * inv - ex[(d * 16 + i) * 64 + lane]; O[d][i] = v; ss += v * v; }
        ss += __shfl_xor(ss, 32);
        const float rstd = rsqrtf(ss * (1.f / 128.f) + EPS) * 0.8f;
        const size_t tok = (size_t)(tok0 + 32 * rg + r);
#pragma unroll
        for (int d = 0; d < 4; ++d)
#pragma unroll
            for (int g = 0; g < 4; ++g) {
                const int dv0 = 32 * d + 8 * g + 4 * h;
                const u32x2 gt = *(const u32x2*)(p.DG + tok * 512 + head * 128 + dv0);
                const f32x4 gn = *(const f32x4*)(p.diff_norm_g + dv0);
                u32x2 w;
                w.x = pk2(O[d][4 * g + 0] * rstd * gn.x * bf2f(gt.x & 0xffffu), O[d][4 * g + 1] * rstd * gn.y * bf2f(gt.x >> 16));
                w.y = pk2(O[d][4 * g + 2] * rstd * gn.z * bf2f(gt.y & 0xffffu), O[d][4 * g + 3] * rstd * gn.w * bf2f(gt.y >> 16));
                *(u32x2*)(p.MIX + tok * 1024 + 512 + head * 128 + dv0) = w;
            }
    }
}

__device__ void ret_scan_item(const Params& p, int seqi, int hd) {
    int tid = threadIdx.x; asm volatile("" : "+v"(tid)); const int lane = tid & 63, wid = tid >> 6, r = lane & 31, h = lane >> 5, dvb = wid >> 1, dkb = wid & 1;
    const bool samp = seqi >= 4; const int sb = seqi - 4;
    const size_t tbase = samp ? TR_S_OFF + (size_t)(sb * 8 + hd) * 4096 : ((size_t)(seqi * 8 + hd) * 128) * 4096;
    const u16* vt = p.RVt + tbase + (size_t)(32 * dvb + r) * 64 + 8 * h;
    const u16* kt = p.RKtd + tbase + (size_t)(32 * dkb + r) * 64 + 8 * h;
    const int nch = samp ? 1 : 128;
    u16* sprev = p.SPREV + (size_t)(samp ? 4096 + sb * 8 + hd : (seqi * 8 + hd) * 128) * 4096;
    float* so = samp ? p.out + O_SS + (size_t)(sb * 8 + hd) * 4096 : p.out + O_SP + (size_t)(seqi * 8 + hd) * 4096;
    const int dk = 32 * dkb + r;
    f32x16 S = zero16();
    if (samp) {
        const float* si = p.state_ret + (size_t)(sb * 8 + hd) * 4096 + (size_t)dk * 64 + 32 * dvb + 4 * h;
#pragma unroll
        for (int g = 0; g < 4; ++g) { const f32x4 v = *(const f32x4*)(si + 8 * g); S[4 * g] = v.x; S[4 * g + 1] = v.y; S[4 * g + 2] = v.z; S[4 * g + 3] = v.w; }
    }
    const float g64 = exp2f(log2_gamma(hd) * 64.f);
    bf16x8 an[4], bn[4];
#pragma unroll
    for (int ks = 0; ks < 4; ++ks) { an[ks] = *(const bf16x8*)(vt + 16 * ks); bn[ks] = *(const bf16x8*)(kt + 16 * ks); }
    for (int c = 0; c < nch; ++c) {
        bf16x8 a[4], b[4];
#pragma unroll
        for (int ks = 0; ks < 4; ++ks) { a[ks] = an[ks]; b[ks] = bn[ks]; }
        if (c + 1 < nch) {
#pragma unroll
            for (int ks = 0; ks < 4; ++ks) { an[ks] = *(const bf16x8*)(vt + (size_t)(c + 1) * 4096 + 16 * ks); bn[ks] = *(const bf16x8*)(kt + (size_t)(c + 1) * 4096 + 16 * ks); }
        }
#pragma unroll
        for (int i = 0; i < 16; ++i) sprev[(size_t)c * 4096 + (32 * dvb + crow(i, h)) * 64 + dk] = f2bf(S[i]);
        f32x16 KV = zero16();
#pragma unroll
        for (int ks = 0; ks < 4; ++ks) KV = MFMA32(a[ks], b[ks], KV);
#pragma unroll
        for (int i = 0; i < 16; ++i) S[i] = g64 * S[i] + KV[i];
    }
#pragma unroll
    for (int g = 0; g < 4; ++g) { f32x4 v = {S[4 * g], S[4 * g + 1], S[4 * g + 2], S[4 * g + 3]}; *(f32x4*)(so + (size_t)dk * 64 + 32 * dvb + 4 * h + 8 * g) = v; }
    asm volatile("s_waitcnt vmcnt(0)" ::: "memory");
    __syncthreads();
    if (tid == 0) {
        __builtin_amdgcn_fence(__ATOMIC_RELEASE, "agent");
        asm volatile("s_waitcnt vmcnt(0)" ::: "memory");
        __hip_atomic_fetch_add(p.done + seqi * 2 + (hd >> 2), 1u, __ATOMIC_RELAXED, __HIP_MEMORY_SCOPE_AGENT);
    }
}

__device__ void p3_tile(const Params& p, int tile, int hh) {
    int tid = threadIdx.x;
    asm volatile("" : "+v"(tid));
    const int lane = tid & 63, wid = tid >> 6, r = lane & 31, h = lane >> 5;
    int hf, tokc, unit0, ustride; size_t vtb, L, pos0;
    if (tile < 1024) { const int b = tile >> 8, c = (tile >> 1) & 127; hf = tile & 1; tokc = b * 8192 + c * 64; unit0 = (b * 8) * 128 + c; ustride = 128; vtb = ((size_t)(b * 8) * 128 + c) * 4096; L = 128 * 4096; pos0 = 0; }
    else { const int k = tile - 1024, sb = k >> 1; hf = k & 1; tokc = TP + sb * 64; unit0 = 4096 + sb * 8; ustride = 1; vtb = TR_S_OFF + (size_t)(sb * 8) * 4096; L = 4096; pos0 = 0; }
    const int tok0 = tokc + 32 * hf;
    const int qi = 32 * hf + r;
    {
        const int hd = 4 * hh + wid;
        const float lg = log2_gamma(hd);
        bf16x8 qf[4];
#pragma unroll
        for (int ks = 0; ks < 4; ++ks) qf[ks] = *(const bf16x8*)(p.RQ + (size_t)(tok0 + r) * 512 + hd * 64 + 16 * ks + 8 * h);
        __builtin_amdgcn_sched_barrier(0);
        f32x16 S0 = zero16(), S1 = zero16();
#pragma unroll
        for (int ks = 0; ks < 4; ++ks) S0 = MFMA32(*(const bf16x8*)(p.RK + (size_t)(tokc + r) * 512 + hd * 64 + 16 * ks + 8 * h), qf[ks], S0);
        if (hf) {
#pragma unroll
            for (int ks = 0; ks < 4; ++ks) S1 = MFMA32(*(const bf16x8*)(p.RK + (size_t)(tokc + 32 + r) * 512 + hd * 64 + 16 * ks + 8 * h), qf[ks], S1);
        }
#pragma unroll
        for (int i = 0; i < 16; ++i) {
            const int k0 = crow(i, h), k1 = 32 + k0;
            S0[i] = qi >= k0 ? S0[i] * __builtin_amdgcn_exp2f(lg * (float)(qi - k0)) : 0.f;
            S1[i] = qi >= k1 ? S1[i] * __builtin_amdgcn_exp2f(lg * (float)(qi - k1)) : 0.f;
        }
        const bf16x8 p00 = pack8<0>(S0), p01 = pack8<1>(S0), p10 = pack8<0>(S1), p11 = pack8<1>(S1);
        __builtin_amdgcn_sched_barrier(0);
        const float qd = __builtin_amdgcn_exp2f(lg * (float)(qi + 1));
        const u16* vt = p.RVt + vtb + (size_t)hd * L + pos0 + 8 * h;
        const u16* sp = p.SPREV + (size_t)(unit0 + hd * ustride) * 4096 + 8 * h;
        float ss = 0.f;
        f32x16 o[2];
#pragma unroll
        for (int d = 0; d < 2; ++d) {
            f32x16 in = zero16(), cr = zero16();
            const u16* vr = vt + (size_t)(32 * d + r) * 64;
            in = MFMA32(*(const bf16x8*)(vr), p00, in);
            in = MFMA32(*(const bf16x8*)(vr + 16), p01, in);
            if (hf) { in = MFMA32(*(const bf16x8*)(vr + 32), p10, in); in = MFMA32(*(const bf16x8*)(vr + 48), p11, in); }
#pragma unroll
            for (int ks = 0; ks < 4; ++ks) cr = MFMA32(*(const bf16x8*)(sp + (32 * d + r) * 64 + 16 * ks), qf[ks], cr);
#pragma unroll
            for (int i = 0; i < 16; ++i) { const float v = in[i] + cr[i] * qd; o[d][i] = v; ss += v * v; }
            __builtin_amdgcn_sched_barrier(0);
        }
        ss += __shfl_xor(ss, 32);
        const float rstd = rsqrtf(ss * (1.f / 64.f) + EPS);
#pragma unroll
        for (int d = 0; d < 2; ++d)
#pragma unroll
            for (int g = 0; g < 4; ++g) {
                const int dv0 = 32 * d + 8 * g + 4 * h;
                const u32x2 gt = *(const u32x2*)(p.RG + (size_t)(tok0 + r) * 512 + hd * 64 + dv0);
                const f32x4 gn = *(const f32x4*)(p.ret_norm_g + hd * 64 + dv0);
                u32x2 w;
                w.x = pk2(o[d][4 * g + 0] * rstd * gn.x * bf2f(gt.x & 0xffffu), o[d][4 * g + 1] * rstd * gn.y * bf2f(gt.x >> 16));
                w.y = pk2(o[d][4 * g + 2] * rstd * gn.z * bf2f(gt.y & 0xffffu), o[d][4 * g + 3] * rstd * gn.w * bf2f(gt.y >> 16));
                *(u32x2*)(p.MIX + (size_t)(tok0 + r) * 1024 + hd * 64 + dv0) = w;
            }
    }
}


constexpr int XQ_ITEMS = 4 + 32 + 256 + 16 + 256 + 16;
DI void wait_done(const Params& p, int idx, int tid) {
    if (tid == 0) {
        unsigned sp = 0;
        while (__hip_atomic_load(p.done + idx, __ATOMIC_RELAXED, __HIP_MEMORY_SCOPE_AGENT) < 4u) { __builtin_amdgcn_s_sleep(2); if (++sp > (1u << 22)) break; }
        __builtin_amdgcn_fence(__ATOMIC_ACQUIRE, "agent");
        asm volatile("s_waitcnt vmcnt(0)" ::: "memory");
    }
    __syncthreads();
}
__device__ void p2_mix(const Params& p, unsigned char* smem) {
    int* s_item = (int*)(smem + 73728);
    int tid = threadIdx.x; asm volatile("" : "+v"(tid));
    const int xcc = (int)(xb_xcc_id() & 7u);
    for (int q = 0; q < 8; ++q) {
        const int x = (xcc + q) & 7;
        while (true) {
            __syncthreads();
            if (tid == 0) *s_item = (int)atomicAdd(p.ctr + x * 32, 1u);
            __syncthreads();
            const int it = __builtin_amdgcn_readfirstlane(*s_item);
            if (it >= XQ_ITEMS) break;
            int kind, arg;
            if (it < 4) { kind = 0; arg = it; }
            else if (it < 36) { kind = 4; arg = it - 4; }
            else if (it < 228) { kind = 1; arg = it - 36; }
            else if (it < 244) { kind = 2; arg = it - 228; }
            else if (it < 564) { const int g = (it - 244) / 10, e = (it - 244) % 10; if (e < 2) { kind = 1; arg = 192 + 2 * g + e; } else { kind = 3; arg = 8 * g + (e - 2); } }
            else { kind = 3; arg = 256 + (it - 564); }
            if (kind == 0) { const int s = 4 * x + arg; ret_scan_item(p, s >> 3, s & 7); }
            else if (kind == 4) { const int k = 32 * x + arg; ret_scan_item(p, 4 + (k >> 3), k & 7); }
            else if (kind == 1) {
                const int k = arg, j = 127 - (k >> 1), bh = 2 * x + (k & 1), b = bh >> 2, hh = bh & 3;
                const int tok0 = b * 8192 + j * 64;
                attn_unit(p, smem, p.DQ + (size_t)tok0 * 512 + hh * 128, p.DKp + (size_t)(bh * 128) * 8192, p.DVtp + (size_t)(bh * 128) * 8192, j + 1, tok0, hh);
            } else if (kind == 2) {
                const int k = 16 * x + arg, sb = k >> 2, hh = k & 3;
                const int tok0 = TP + sb * 64;
                attn_unit(p, smem, p.DQ + (size_t)tok0 * 512 + hh * 128, p.SK + (size_t)(k * 17) * 8192, p.SVt + (size_t)(k * 17) * 8192, 17, tok0, hh);
            } else if (arg < 256) {
                const int b = x >> 1, hh = x & 1;
                wait_done(p, b * 2 + hh, tid);
                p3_tile(p, b * 256 + arg, hh);
            } else {
                const int k = arg - 256, sb = 4 * x + (k >> 2), hf = (k >> 1) & 1, hh = k & 1;
                wait_done(p, (4 + sb) * 2 + hh, tid);
                p3_tile(p, 1024 + sb * 2 + hf, hh);
            }
        }
    }
}

template <int MI> DI void p5_tile(const Params& p, unsigned char* smem, int row0, int nt, int tid) {
    f32x16 acc[MI][2];
    gemm_core<MI>(p.MIX + (size_t)row0 * 1024, p.WtOut + (size_t)nt * 128 * 1024, (u16*)smem, acc, tid);
    const int lane = tid & 63, wid = tid >> 6, r = lane & 31, h = lane >> 5, wm = wid >> 1, wn = wid & 1;
    float* red = (float*)smem;
    __syncthreads();
#pragma unroll
    for (int mi = 0; mi < MI; ++mi) {
        const int rl = wm * 32 * MI + mi * 32, tok0 = row0 + rl;
        const float* xb = (tok0 < TP ? p.x_p + (size_t)tok0 * D : p.x_s + (size_t)(tok0 - TP) * D) + nt * 128 + wn * 64 + r;
        float* yb = p.out + O_Y + (size_t)tok0 * D + nt * 128 + wn * 64 + r;
#pragma unroll
        for (int i = 0; i < 16; ++i) {
            const size_t ro = (size_t)crow(i, h) * D;
            const float v0 = acc[mi][0][i] + __builtin_nontemporal_load(xb + ro), v1 = acc[mi][1][i] + __builtin_nontemporal_load(xb + ro + 32);
            yb[ro] = v0; yb[ro + 32] = v1;
            float s = v0 * v0 + v1 * v1;
#pragma unroll
            for (int o = 1; o <= 16; o <<= 1) s += __shfl_xor(s, o);
            if (r == 0) red[wn * 64 * MI + rl + crow(i, h)] = s;
        }
    }
    __syncthreads();
    if (tid < 64 * MI) unsafeAtomicAdd(p.rowss + row0 + tid, red[tid] + red[64 * MI + tid]);
}
__device__ void p5_gemm(const Params& p, unsigned char* smem) {
    for (int tile_ = blockIdx.x; tile_ < (1024 + 256) * REP5; tile_ += gridDim.x) {
        int tid = threadIdx.x; asm volatile("" : "+v"(tid));
        const int tile = tile_ % (1024 + 256);
        if (tile < 1024) p5_tile<4>(p, smem, (tile >> 3) * 256, tile & 7, tid);
        else { const int t = tile - 1024; p5_tile<1>(p, smem, TP + (t >> 3) * 64, t & 7, tid); }
    }
}

__device__ void p6_norm(const Params& p) {
    const int tid = threadIdx.x, lane = tid & 63, wid = tid >> 6;
    f32x4 g[4];
#pragma unroll
    for (int i = 0; i < 4; ++i) g[i] = *(const f32x4*)(p.final_g + (lane + 64 * i) * 4);
    for (int row = (blockIdx.x * 4 + wid) * 2; row < T; row += gridDim.x * 8) {
        f32x4 v[2][4];
#pragma unroll
        for (int q = 0; q < 2; ++q)
#pragma unroll
            for (int i = 0; i < 4; ++i) v[q][i] = __builtin_nontemporal_load((const f32x4*)(p.out + O_Y + (size_t)(row + q) * D + (lane + 64 * i) * 4));
#pragma unroll
        for (int q = 0; q < 2; ++q) {
            const float rs = rsqrtf(p.rowss[row + q] * (1.f / 1024.f) + EPS);
#pragma unroll
            for (int i = 0; i < 4; ++i) { f32x4 o = v[q][i] * g[i] * rs; __builtin_nontemporal_store(o, (f32x4*)(p.out + O_Y + (size_t)(row + q) * D + (lane + 64 * i) * 4)); }
        }
    }
}

#define SMEM_DECL __shared__ __attribute__((aligned(16))) unsigned char smem[LDS_BYTES]
#if MULTI_LAUNCH
__global__ void __launch_bounds__(NTHREADS, 2) k_p0(Params p) { SMEM_DECL; p0_prep(p, smem); }
__global__ void __launch_bounds__(NTHREADS, 2) k_p1(Params p) { SMEM_DECL; p1_gemm(p, smem); }
__global__ void __launch_bounds__(NTHREADS, 2) k_p2(Params p) { SMEM_DECL; p2_mix(p, smem); }
__global__ void __launch_bounds__(NTHREADS, 2) k_p5(Params p) { SMEM_DECL; p5_gemm(p, smem); }
__global__ void __launch_bounds__(NTHREADS, 2) k_p6(Params p) { p6_norm(p); }
#else
__global__ void __launch_bounds__(NTHREADS, 2) fwd_megakernel(Params p) {
    SMEM_DECL;
    __shared__ uint4 xb_words;
    cg::grid_group grid = cg::this_grid();
    if (p.never) grid.sync();
    if (threadIdx.x == 0) xb_words = make_uint4(0u, 0u, 0u, 0u);
    __syncthreads();
    const XcdBarrier xb = xcd_barrier_post(p.bar, (volatile LAS unsigned*)&xb_words);
#pragma nounroll
    for (int rep = 0; rep < REP0; ++rep) p0_prep(p, smem);
    xcd_barrier(xb);
    p1_gemm(p, smem);
    xcd_barrier(xb);
    p2_mix(p, smem);
    xcd_barrier(xb);
    p5_gemm(p, smem);
    xcd_barrier(xb);
    p6_norm(p);
}
#endif

extern "C" void kernel_launch(void* const* d_in, const int* in_sizes, int n_in, void* d_out, int out_size, void* d_ws, size_t ws_size, hipStream_t stream) {
    Params p{};
    p.x_p = (const float*)d_in[0]; p.x_s = (const float*)d_in[1]; p.cache_k = (const float*)d_in[2]; p.cache_v = (const float*)d_in[3]; p.state_ret = (const float*)d_in[4];
    p.norm_g = (const float*)d_in[5]; p.w_in = (const float*)d_in[6]; p.w_out = (const float*)d_in[7]; p.ret_norm_g = (const float*)d_in[8]; p.diff_norm_g = (const float*)d_in[9];
    p.lam_q1 = (const float*)d_in[10]; p.lam_k1 = (const float*)d_in[11]; p.lam_q2 = (const float*)d_in[12]; p.lam_k2 = (const float*)d_in[13]; p.final_g = (const float*)d_in[14];
    p.out = (float*)d_out;
    unsigned char* w = (unsigned char*)d_ws; size_t off = 0;
    auto take = [&](size_t bytes) { unsigned char* r = w + off; off += (bytes + 255) & ~(size_t)255; return r; };
    const size_t HALF = (size_t)T * 512 * 2;
    p.H = (u16*)take(2 * HALF);
    p.MIX = p.H; p.SPREV = (u16*)take(HALF);
    p.WtIn = (u16*)take((size_t)4096 * 1024 * 2); p.WtOut = (u16*)take((size_t)1024 * 1024 * 2);
    p.RQ = (u16*)take(HALF); p.RK = (u16*)take(HALF); p.RKtd = (u16*)take(HALF); p.RVt = (u16*)take(HALF); p.RG = (u16*)take(HALF); p.DQ = (u16*)take(HALF); p.DG = (u16*)take(HALF);
    p.cosR = (float*)take(8192 * 32 * 4); p.sinR = (float*)take(8192 * 32 * 4); p.cosD = (float*)take(8192 * 8 * 4); p.sinD = (float*)take(8192 * 8 * 4);
    p.misc = (float*)take(256); p.ctr = (unsigned*)take(2048); p.done = (unsigned*)take(512); p.rowss = (float*)take((size_t)T * 4); p.bar = (unsigned*)take(XCD_BAR_WORDS * 4);
    unsigned char* yo = (unsigned char*)d_out; size_t yoff = 0;
    auto takey = [&](size_t bytes) { unsigned char* r = yo + yoff; yoff += (bytes + 255) & ~(size_t)255; return r; };
    p.DKp = (u16*)takey((size_t)TP * 512 * 2); p.SK = (u16*)takey((size_t)32 * SKL * 512 * 2); p.DVtp = (u16*)takey((size_t)2048 * 8192 * 2); p.SVt = (u16*)takey((size_t)16384 * SKL * 2);
    if (off > ws_size || yoff > (size_t)35651584 * 4) { fprintf(stderr, "workspace too small: need %zu have %zu\n", off, ws_size); return; }
#if MULTI_LAUNCH
    static int gb = 0;
    if (!gb) { int dev = 0, cus = 0; hipGetDevice(&dev); hipDeviceGetAttribute(&cus, hipDeviceAttributeMultiprocessorCount, dev); gb = cus * 2; }
    k_p0<<<gb, NTHREADS, 0, stream>>>(p); k_p1<<<gb, NTHREADS, 0, stream>>>(p); k_p2<<<gb, NTHREADS, 0, stream>>>(p); k_p5<<<gb, NTHREADS, 0, stream>>>(p); k_p6<<<gb, NTHREADS, 0, stream>>>(p);
#else
    static int grid_blocks = 0;
    if (!grid_blocks) {
        int dev = 0, cus = 0, per_cu = 0;
        hipGetDevice(&dev); hipDeviceGetAttribute(&cus, hipDeviceAttributeMultiprocessorCount, dev);
        hipOccupancyMaxActiveBlocksPerMultiprocessor(&per_cu, fwd_megakernel, NTHREADS, 0);
        if (per_cu > 2) per_cu = 2;
        if (per_cu < 1) per_cu = 1;
        grid_blocks = cus * per_cu;
    }
    hipMemsetAsync(p.bar, 0, XCD_BAR_WORDS * 4, stream);
    void* args[] = {&p};
    hipError_t e = hipLaunchCooperativeKernel((void*)fwd_megakernel, dim3(grid_blocks), dim3(NTHREADS), args, 0, stream);
    if (e != hipSuccess) fprintf(stderr, "cooperative launch failed: %s (grid %d)\n", hipGetErrorString(e), grid_blocks);
#endif
}
```

```cpp
#include <hip/hip_runtime.h>
#include <hip/hip_cooperative_groups.h>
#include <cstdio>
#include <cstdint>
namespace cg = cooperative_groups;

#ifndef REP1
#define REP1 1
#endif
#ifndef REP3
#define REP3 1
#endif
#ifndef REP5
#define REP5 1
#endif
#ifndef REP0
#define REP0 1
#endif
#ifndef MULTI_LAUNCH
#define MULTI_LAUNCH 0
#endif

typedef unsigned short u16;
typedef short bf16x8 __attribute__((ext_vector_type(8)));
typedef float f32x4 __attribute__((ext_vector_type(4)));
typedef float f32x2 __attribute__((ext_vector_type(2)));
typedef float f32x16 __attribute__((ext_vector_type(16)));
typedef unsigned u32x4 __attribute__((ext_vector_type(4)));
typedef unsigned u32x2 __attribute__((ext_vector_type(2)));
typedef __bf16 bf16x2_t __attribute__((ext_vector_type(2)));

#define DI __device__ __forceinline__
#define MFMA32(a, b, c) __builtin_amdgcn_mfma_f32_32x32x16_bf16((a), (b), (c), 0, 0, 0)

constexpr int D = 1024, TP = 32768, TS = 2048, T = TP + TS, PAST = 1024, SKL = 1088;
constexpr int NTHREADS = 256;
constexpr int LDS_BYTES = 73728 + 64;
constexpr float EPS = 1e-6f;
constexpr float QSCALE = 0.125f * 1.4426950408889634f;
constexpr size_t O_Y = 0, O_SP = 35651584, O_SS = 35782656, O_KP = 36831232, O_VP = 53608448, O_KS = 70385664, O_VS = 71434240;
constexpr size_t TR_S_OFF = 16777216;
constexpr int NITEMS = 32 + 2048 + 128 + 256;

struct Params {
    const float *x_p, *x_s, *cache_k, *cache_v, *state_ret, *norm_g, *w_in, *w_out, *ret_norm_g, *diff_norm_g, *lam_q1, *lam_k1, *lam_q2, *lam_k2, *final_g;
    float* out;
    u16 *H, *WtIn, *WtOut, *RQ, *RK, *RKtd, *RVt, *RG, *DQ, *DKp, *SK, *DVtp, *SVt, *DG, *MIX, *SPREV;
    float *cosR, *sinR, *cosD, *sinD, *misc, *rowss;
    unsigned* ctr; unsigned* bar; unsigned* done;
    int never; int pad_;
};

DI unsigned pk2(float lo, float hi) { f32x2 v = {lo, hi}; bf16x2_t b = __builtin_convertvector(v, bf16x2_t); return __builtin_bit_cast(unsigned, b); }
DI u16 f2bf(float x) { return (u16)(pk2(x, 0.f) & 0xffffu); }
DI float bf2f(unsigned v) { return __uint_as_float(v << 16); }
DI int crow(int i, int h) { return (i & 3) + 8 * (i >> 2) + 4 * h; }
DI float silu(float v) { return v / (1.f + __expf(-v)); }
DI float log2_gamma(int hd) {
    const float x = exp2f(-5.f - (float)hd);
    float s = x * (1.f + x * (0.5f + x * (1.f / 3.f + x * (0.25f + x * (0.2f + x * (1.f / 6.f))))));
    return -s * 1.4426950408889634f;
}
template <int S> DI bf16x8 pack8(const f32x16& x) {
    u32x4 p;
    p.x = pk2(x[8 * S + 0], x[8 * S + 1]); p.y = pk2(x[8 * S + 2], x[8 * S + 3]);
    p.z = pk2(x[8 * S + 4], x[8 * S + 5]); p.w = pk2(x[8 * S + 6], x[8 * S + 7]);
    return __builtin_bit_cast(bf16x8, p);
}
DI float xhalf_max(float v) { auto r = __builtin_amdgcn_permlane32_swap(__float_as_uint(v), __float_as_uint(v), false, false); return fmaxf(__uint_as_float(r[0]), __uint_as_float(r[1])); }
DI float xhalf_sum(float v) { auto r = __builtin_amdgcn_permlane32_swap(__float_as_uint(v), __float_as_uint(v), false, false); return __uint_as_float(r[0]) + __uint_as_float(r[1]); }
DI f32x16 zero16() { f32x16 z; for (int i = 0; i < 16; ++i) z[i] = 0.f; return z; }


#define XB_TMO      128
#define XB_XCNT(j)  (256  + 64 * (j))
#define XB_XSUB(j)  (1280 + 64 * (j))
#define XB_XGEN(j)  (2304 + 64 * (j))
#define XB_TOP      3328
#define XB_TOPGEN   3392
#define XCD_BAR_WORDS 3456
#define XB_SPIN_CAP (1u << 20)
#define LAS __attribute__((address_space(3)))
DI unsigned xb_ld(unsigned* p)              { return __hip_atomic_load(p, __ATOMIC_RELAXED, __HIP_MEMORY_SCOPE_AGENT); }
DI unsigned xb_add(unsigned* p, unsigned v) { return __hip_atomic_fetch_add(p, v, __ATOMIC_RELAXED, __HIP_MEMORY_SCOPE_AGENT); }
DI unsigned xb_xcc_id() { return (unsigned)__builtin_amdgcn_s_getreg((3 << 11) | 20) & 0xFu; }
#define XB_SPIN(cond, bar) do { unsigned _sp = 0; while (cond) { __builtin_amdgcn_s_sleep(1); \
    if ((++_sp & 255u) == 0u) { if (xb_ld(&(bar)[XB_TMO])) break; if (_sp > XB_SPIN_CAP) { atomicAdd(&(bar)[XB_TMO], 1u); break; } } } } while (0)
struct XcdBarrier { unsigned* bar; unsigned x; volatile LAS unsigned* st; };
DI XcdBarrier xcd_barrier_post(unsigned* bar, volatile LAS unsigned* st) {
    XcdBarrier b; b.bar = bar; b.x = xb_xcc_id(); b.st = st;
    if (threadIdx.x == 0) (void)xb_add(&bar[XB_XCNT(b.x)], 1u);
    return b;
}
DI void xcd_barrier_complete(unsigned* bar, unsigned x, unsigned& nloc, unsigned& nx) {
    const unsigned G = gridDim.x * gridDim.y * gridDim.z;
    unsigned sum, cnt, mine, sp = 0u;
    for (;;) {
        sum = 0u; cnt = 0u; mine = 0u;
#pragma unroll
        for (unsigned j = 0; j < 16; ++j) { const unsigned c = xb_ld(&bar[XB_XCNT(j)]); sum += c; cnt += (c > 0u) ? 1u : 0u; mine = (j == x) ? c : mine; }
        if (sum == G) break;
        __builtin_amdgcn_s_sleep(1);
        if ((++sp & 255u) == 0u) { if (xb_ld(&bar[XB_TMO])) break; if (sp > XB_SPIN_CAP) { atomicAdd(&bar[XB_TMO], 1u); break; } }
    }
    nloc = mine > 0u ? mine : 1u; nx = cnt > 0u ? cnt : 1u;
}
DI void xcd_barrier(const XcdBarrier& b) {
    asm volatile("s_waitcnt vmcnt(0)" ::: "memory");
    __syncthreads();
    if (threadIdx.x == 0) {
        unsigned* bar = b.bar;
        __builtin_amdgcn_s_waitcnt(0);
        unsigned nloc = b.st[0], nx = b.st[1];
        if (nloc == 0u) { xcd_barrier_complete(bar, b.x, nloc, nx); b.st[0] = nloc; b.st[1] = nx; }
        const unsigned old = xb_add(&bar[XB_XSUB(b.x)], 1u);
        const unsigned gen = old / nloc;
        if (old + 1u == (gen + 1u) * nloc) {
            __builtin_amdgcn_fence(__ATOMIC_RELEASE, "agent");
            asm volatile("s_waitcnt vmcnt(0)" ::: "memory");
            const unsigned og = xb_add(&bar[XB_TOP], 1u);
            const unsigned tg = og / nx;
            if (og + 1u == (tg + 1u) * nx) xb_add(&bar[XB_TOPGEN], 1u);
            else XB_SPIN(xb_ld(&bar[XB_TOPGEN]) == tg, bar);
            __builtin_amdgcn_fence(__ATOMIC_ACQUIRE, "agent");
            xb_add(&bar[XB_XGEN(b.x)], 1u);
            asm volatile("s_waitcnt vmcnt(0)" ::: "memory");
        } else {
            XB_SPIN(xb_ld(&bar[XB_XGEN(b.x)]) == gen, bar);
            __builtin_amdgcn_fence(__ATOMIC_ACQUIRE, "agent");
            asm volatile("s_waitcnt vmcnt(0)" ::: "memory");
        }
    }
    __syncthreads();
}

struct TJob { const float* src; size_t ss; u16* dst; size_t ds; bool perm; };
DI TJob tjob(const Params& p, int t) {
    TJob j;
    if (t < 1024) { const int kt = t >> 6, nt = t & 63;
        j.src = p.w_in + (size_t)kt * 64 * 4096 + nt * 64; j.ss = 4096; j.dst = p.WtIn + (size_t)nt * 64 * 1024 + kt * 64; j.ds = 1024; j.perm = false;
    } else if (t < 1280) { const int q = t - 1024, kt = q >> 4, nt = q & 15;
        j.src = p.w_out + (size_t)kt * 64 * 1024 + nt * 64; j.ss = 1024; j.dst = p.WtOut + (size_t)nt * 64 * 1024 + kt * 64; j.ds = 1024; j.perm = false;
    } else { const int q = t - 1280, sbh = q >> 5, keyt = (q >> 1) & 15, dvt = q & 1, sb = sbh >> 2, hh = sbh & 3;
        j.src = p.cache_v + ((size_t)sb * 1024 + keyt * 64) * 512 + hh * 128 + dvt * 64; j.ss = 512; j.dst = p.SVt + ((size_t)sbh * 17 + keyt) * 8192 + dvt * 64 * 64; j.ds = 64; j.perm = true;
    }
    return j;
}
DI void tr_load(const TJob& j, f32x4 (&v)[4], int tid) {
#pragma unroll
    for (int i = 0; i < 4; ++i) v[i] = __builtin_nontemporal_load((const f32x4*)(j.src + (size_t)((tid >> 4) + 16 * i) * j.ss + (tid & 15) * 4));
}
DI void tr_put(const f32x4 (&v)[4], float* tile, int tid) {
#pragma unroll
    for (int i = 0; i < 4; ++i) { const int r = (tid >> 4) + 16 * i, c4 = (tid & 15) * 4;
        tile[(c4 + 0) * 65 + r] = v[i].x; tile[(c4 + 1) * 65 + r] = v[i].y; tile[(c4 + 2) * 65 + r] = v[i].z; tile[(c4 + 3) * 65 + r] = v[i].w; }
}
DI void tr_store(const TJob& j, const float* tile, int tid) {
#pragma unroll
    for (int i = 0; i < 2; ++i) {
        const int id = tid + 256 * i, c = id >> 3, p0 = (id & 7) * 8;
        float e[8];
#pragma unroll
        for (int jj = 0; jj < 8; ++jj) { const int pos = p0 + jj; const int r = j.perm ? ((pos & ~12) | ((pos & 4) << 1) | ((pos & 8) >> 1)) : pos; e[jj] = tile[c * 65 + r]; }
        u32x4 w; w.x = pk2(e[0], e[1]); w.y = pk2(e[2], e[3]); w.z = pk2(e[4], e[5]); w.w = pk2(e[6], e[7]);
        *(u32x4*)(j.dst + (size_t)c * j.ds + p0) = w;
    }
}

__device__ void p0_prep(const Params& p, unsigned char* smem) {
    int tid = threadIdx.x; asm volatile("" : "+v"(tid)); const int lane = tid & 63, wid = tid >> 6, nb = gridDim.x, bid = blockIdx.x;
    if (bid == 0 && tid == 0) {
        float s1 = 0.f, s2 = 0.f;
        for (int i = 0; i < 64; ++i) { s1 += p.lam_q1[i] * p.lam_k1[i]; s2 += p.lam_q2[i] * p.lam_k2[i]; }
        p.misc[0] = expf(s1) - expf(s2) + 0.2f;
        for (int i = 0; i < 288; ++i) p.ctr[i] = 0u;
        for (int i = 0; i < 128; ++i) p.done[i] = 0u;
    }
    for (int i = bid * 256 + tid; i < T; i += nb * 256) p.rowss[i] = 0.f;
    for (int row = (bid * 4 + wid) * 2; row < T; row += nb * 8) {
        f32x4 v[2][4]; float ss[2] = {0.f, 0.f};
#pragma unroll
        for (int q = 0; q < 2; ++q) { const int rw = row + q; const float* src = rw < TP ? p.x_p + (size_t)rw * D : p.x_s + (size_t)(rw - TP) * D;
#pragma unroll
            for (int i = 0; i < 4; ++i) v[q][i] = __builtin_nontemporal_load((const f32x4*)(src + (lane + 64 * i) * 4)); }
        f32x4 g[4];
#pragma unroll
        for (int i = 0; i < 4; ++i) g[i] = *(const f32x4*)(p.norm_g + (lane + 64 * i) * 4);
#pragma unroll
        for (int q = 0; q < 2; ++q) {
#pragma unroll
            for (int i = 0; i < 4; ++i) ss[q] += v[q][i].x * v[q][i].x + v[q][i].y * v[q][i].y + v[q][i].z * v[q][i].z + v[q][i].w * v[q][i].w;
#pragma unroll
            for (int o = 32; o >= 1; o >>= 1) ss[q] += __shfl_xor(ss[q], o);
            const float rstd = rsqrtf(ss[q] * (1.f / 1024.f) + EPS);
#pragma unroll
            for (int i = 0; i < 4; ++i) {
                u32x2 w; w.x = pk2(v[q][i].x * rstd * g[i].x, v[q][i].y * rstd * g[i].y); w.y = pk2(v[q][i].z * rstd * g[i].z, v[q][i].w * rstd * g[i].w);
                *(u32x2*)(p.H + (size_t)(row + q) * D + (lane + 64 * i) * 4) = w;
            }
        }
    }
    float* tile0 = (float*)smem; float* tile1 = tile0 + 64 * 65;
    for (int t = bid; t < 1280; t += 2 * nb) {
        const bool two = t + nb < 1280;
        const TJob j0 = tjob(p, t), j1 = tjob(p, two ? t + nb : t);
        f32x4 v0[4], v1[4];
        tr_load(j0, v0, tid); if (two) tr_load(j1, v1, tid);
        __syncthreads();
        tr_put(v0, tile0, tid); if (two) tr_put(v1, tile1, tid);
        __syncthreads();
        tr_store(j0, tile0, tid); if (two) tr_store(j1, tile1, tid);
    }
    for (int i = bid * 256 + tid; i < 8192 * 40; i += nb * 256) {
        const int pos = i / 40, f = i % 40;
        const float inv = f < 32 ? exp2f(-13.287712379549449f * (float)f * (1.f / 32.f)) : exp2f(-18.931568569324174f * (float)(f - 32) * (1.f / 8.f));
        const float ang = (float)pos * inv;
        const double rev = (double)ang * 0.15915494309189535; const float fr = (float)(rev - rint(rev));
        const float sn = __builtin_amdgcn_sinf(fr), cs = __builtin_amdgcn_cosf(fr);
        if (f < 32) { p.cosR[pos * 32 + f] = cs; p.sinR[pos * 32 + f] = sn; } else { p.cosD[pos * 8 + f - 32] = cs; p.sinD[pos * 8 + f - 32] = sn; }
    }
}

DI void stage_store(float* stg, const float (&v0)[16], const float (&v1)[16], u16* base, size_t ld, int lane, bool nt = true) {
    const int r = lane & 31, h = lane >> 5;
#pragma unroll
    for (int i = 0; i < 16; ++i) { stg[crow(i, h) * 68 + r] = v0[i]; stg[crow(i, h) * 68 + 32 + r] = v1[i]; }
    __builtin_amdgcn_wave_barrier();
#pragma unroll
    for (int j = 0; j < 4; ++j) {
        const int row = (lane >> 3) + 8 * j, ch = lane & 7;
        const f32x4 x = *(const f32x4*)(stg + row * 68 + ch * 8), y = *(const f32x4*)(stg + row * 68 + ch * 8 + 4);
        u32x4 w; w.x = pk2(x.x, x.y); w.y = pk2(x.z, x.w); w.z = pk2(y.x, y.y); w.w = pk2(y.z, y.w);
        if (nt) __builtin_nontemporal_store(w, (u32x4*)(base + (size_t)row * ld + ch * 8));
        else *(u32x4*)(base + (size_t)row * ld + ch * 8) = w;
    }
    __builtin_amdgcn_wave_barrier();
}
DI void store_tr(u16* tb, const float (&v0)[16], const float (&v1)[16], int r, int h, bool nt = true) {
#pragma unroll
    for (int G = 0; G < 2; ++G) {
        u32x4 w0, w1;
        w0.x = pk2(v0[8 * G + 0], v0[8 * G + 1]); w0.y = pk2(v0[8 * G + 2], v0[8 * G + 3]); w0.z = pk2(v0[8 * G + 4], v0[8 * G + 5]); w0.w = pk2(v0[8 * G + 6], v0[8 * G + 7]);
        w1.x = pk2(v1[8 * G + 0], v1[8 * G + 1]); w1.y = pk2(v1[8 * G + 2], v1[8 * G + 3]); w1.z = pk2(v1[8 * G + 4], v1[8 * G + 5]); w1.w = pk2(v1[8 * G + 6], v1[8 * G + 7]);
        if (nt) { __builtin_nontemporal_store(w0, (u32x4*)(tb + (size_t)r * 64 + 16 * G + 8 * h)); __builtin_nontemporal_store(w1, (u32x4*)(tb + (size_t)(32 + r) * 64 + 16 * G + 8 * h)); }
        else { *(u32x4*)(tb + (size_t)r * 64 + 16 * G + 8 * h) = w0; *(u32x4*)(tb + (size_t)(32 + r) * 64 + 16 * G + 8 * h) = w1; }
    }
}
template <int MI> DI void p1_epilogue(const Params& p, const f32x16 (&acc)[MI][2], int mt, int nt, int wm, int wn, int lane, float* stg) {
    const int r = lane & 31, h = lane >> 5;
    const int seg = nt >> 2;
    const int cseg0 = (nt & 3) * 128 + wn * 64;
#pragma unroll
    for (int mi = 0; mi < MI; ++mi) {
        const int tok0 = mt * (64 * MI) + wm * (32 * MI) + mi * 32;
        const bool samp = tok0 >= TP;
        int bseq, t0;
        if (!samp) { bseq = tok0 >> 13; t0 = tok0 & 8191; } else { const int st = tok0 - TP; bseq = st >> 6; t0 = st & 63; }
        const int pos0 = samp ? PAST + t0 : t0;
        float v0[16], v1[16];
        if (seg == 0 || seg == 1) {
            const int head = cseg0 >> 6;
            const float sc = seg == 0 ? 1.f : 0.125f;
            {
                const int pb = pos0 + 4 * h;
                float cg = p.cosR[pb * 32 + r], sg = p.sinR[pb * 32 + r];
                const float c1 = p.cosR[32 + r], s1 = p.sinR[32 + r], c8 = p.cosR[256 + r], s8 = p.sinR[256 + r];
#pragma unroll
                for (int g = 0; g < 4; ++g) {
                    float c = cg, s = sg;
#pragma unroll
                    for (int b = 0; b < 4; ++b) {
                        const int i = 4 * g + b;
                        const float a0 = acc[mi][0][i], a1 = acc[mi][1][i];
                        v0[i] = (a0 * c - a1 * s) * sc; v1[i] = (a1 * c + a0 * s) * sc;
                        const float cn = c * c1 - s * s1, sn = s * c1 + c * s1; c = cn; s = sn;
                    }
                    const float cn = cg * c8 - sg * s8, sn = sg * c8 + cg * s8; cg = cn; sg = sn;
                }
            }
            stage_store(stg, v0, v1, (seg == 0 ? p.RQ : p.RK) + (size_t)tok0 * 512 + cseg0, 512, lane);
            if (seg == 1) {
                const float lg = log2_gamma(head);
                u16* tb = (samp ? p.RKtd + TR_S_OFF + (size_t)(bseq * 8 + head) * 4096 : p.RKtd + ((size_t)(bseq * 8 + head) * 128 + (t0 >> 6)) * 4096) + (t0 & 63);
#pragma unroll
                for (int i = 0; i < 16; ++i) { const float dc = __builtin_amdgcn_exp2f(lg * (float)(63 - ((t0 + crow(i, h)) & 63))); v0[i] *= dc; v1[i] *= dc; }
                store_tr(tb, v0, v1, r, h);
            }
        } else if (seg == 2) {
            const int head = cseg0 >> 6;
            u16* tb = (samp ? p.RVt + TR_S_OFF + (size_t)(bseq * 8 + head) * 4096 : p.RVt + ((size_t)(bseq * 8 + head) * 128 + (t0 >> 6)) * 4096) + (t0 & 63);
#pragma unroll
            for (int i = 0; i < 16; ++i) { v0[i] = acc[mi][0][i]; v1[i] = acc[mi][1][i]; }
            store_tr(tb, v0, v1, r, h);
        } else if (seg == 3 || seg == 7) {
#pragma unroll
            for (int i = 0; i < 16; ++i) { v0[i] = silu(acc[mi][0][i]); v1[i] = silu(acc[mi][1][i]); }
            stage_store(stg, v0, v1, (seg == 3 ? p.RG : p.DG) + (size_t)tok0 * 512 + cseg0, 512, lane);
        } else if (seg == 4 || seg == 5) {
            {
                const int pb = pos0 + 4 * h, f = r & 7;
                float cg = p.cosD[pb * 8 + f], sg = p.sinD[pb * 8 + f];
                const float c1 = p.cosD[8 + f], s1 = p.sinD[8 + f], c8 = p.cosD[64 + f], s8 = p.sinD[64 + f];
#pragma unroll
                for (int g = 0; g < 4; ++g) {
                    float c = cg, s = sg;
#pragma unroll
                    for (int b = 0; b < 4; ++b) {
                        const int i = 4 * g + b;
                        const float v = acc[mi][0][i], pr = __int_as_float(__builtin_amdgcn_update_dpp(0, __float_as_int(v), 0x128, 0xf, 0xf, false));
                        v0[i] = r < 8 ? v * c - pr * s : (r < 16 ? v * c + pr * s : v); v1[i] = acc[mi][1][i];
                        const float cn = c * c1 - s * s1, sn = s * c1 + c * s1; c = cn; s = sn;
                    }
                    const float cn = cg * c8 - sg * s8, sn = sg * c8 + cg * s8; cg = cn; sg = sn;
                }
            }
            if (seg == 4) {
#pragma unroll
                for (int i = 0; i < 16; ++i) { v0[i] *= QSCALE; v1[i] *= QSCALE; }
                stage_store(stg, v0, v1, p.DQ + (size_t)tok0 * 512 + cseg0, 512, lane);
            } else {
                float* ko = (samp ? p.out + O_KS + (size_t)(tok0 - TP) * 512 : p.out + O_KP + (size_t)tok0 * 512) + cseg0 + r;
                const int head4 = cseg0 >> 7, colh = cseg0 & 127;
                u16* kb = (samp ? p.SK + ((size_t)(bseq * 4 + head4) * 17 + 16) * 8192 : p.DKp + ((size_t)(bseq * 4 + head4) * 128 + (t0 >> 6)) * 8192) + (t0 & 63) * 128 + colh;
#pragma unroll
                for (int i = 0; i < 16; ++i) { const size_t ro = (size_t)crow(i, h) * 512; __builtin_nontemporal_store(v0[i], ko + ro); __builtin_nontemporal_store(v1[i], ko + ro + 32); }
                stage_store(stg, v0, v1, kb, 128, lane, false);
            }
        } else {
            float* vo = (samp ? p.out + O_VS + (size_t)(tok0 - TP) * 512 : p.out + O_VP + (size_t)tok0 * 512) + cseg0 + r;
            const int head4 = cseg0 >> 7, dv0 = cseg0 & 127;
            u16* tb = (samp ? p.SVt + ((size_t)(bseq * 4 + head4) * 17 + 16) * 8192 : p.DVtp + ((size_t)(bseq * 4 + head4) * 128 + (t0 >> 6)) * 8192) + dv0 * 64 + (t0 & 63);
#pragma unroll
            for (int i = 0; i < 16; ++i) { v0[i] = acc[mi][0][i]; v1[i] = acc[mi][1][i]; const size_t ro = (size_t)crow(i, h) * 512; __builtin_nontemporal_store(v0[i], vo + ro); __builtin_nontemporal_store(v1[i], vo + ro + 32); }
            store_tr(tb, v0, v1, r, h, false);
        }
    }
}

template <int MI> DI void gemm_core(const u16* __restrict__ Ag, const u16* __restrict__ Bg, u16* smem16, f32x16 (&acc)[MI][2], int tid) {
    constexpr int AST = 64 * MI * 40, STAGE = AST + 128 * 40;
    const int lane = tid & 63, wid = tid >> 6, r = lane & 31, h = lane >> 5, wm = wid >> 1, wn = wid & 1, lrow = tid >> 2, lch = tid & 3;
    const u16* ag = Ag + (size_t)lrow * 1024 + lch * 8; const u16* bg = Bg + (size_t)lrow * 1024 + lch * 8;
    const int wofs = lrow * 40 + lch * 8;
    const int afo = (32 * MI * wm + r) * 40 + 8 * h, bfo = AST + (64 * wn + r) * 40 + 8 * h;
#pragma unroll
    for (int a = 0; a < MI; ++a) { acc[a][0] = zero16(); acc[a][1] = zero16(); }
    u32x4 ra[MI], rb[2];
#pragma unroll
    for (int i = 0; i < MI; ++i) ra[i] = *(const u32x4*)(ag + (size_t)i * 64 * 1024);
#pragma unroll
    for (int i = 0; i < 2; ++i) rb[i] = *(const u32x4*)(bg + (size_t)i * 64 * 1024);
    __syncthreads();
#pragma unroll
    for (int i = 0; i < MI; ++i) *(u32x4*)(smem16 + wofs + i * 64 * 40) = ra[i];
#pragma unroll
    for (int i = 0; i < 2; ++i) *(u32x4*)(smem16 + AST + wofs + i * 64 * 40) = rb[i];
#pragma unroll
    for (int i = 0; i < MI; ++i) ra[i] = *(const u32x4*)(ag + (size_t)i * 64 * 1024 + 32);
#pragma unroll
    for (int i = 0; i < 2; ++i) rb[i] = *(const u32x4*)(bg + (size_t)i * 64 * 1024 + 32);
    __syncthreads();
    for (int kt = 0; kt < 32; ++kt) {
        const u16* cur = smem16 + (kt & 1) * STAGE;
        u16* nxt = smem16 + ((kt & 1) ^ 1) * STAGE;
        bf16x8 a0[MI], b0[2], a1[MI], b1[2];
#pragma unroll
        for (int mi = 0; mi < MI; ++mi) a0[mi] = *(const bf16x8*)(cur + afo + mi * 32 * 40);
#pragma unroll
        for (int ni = 0; ni < 2; ++ni) b0[ni] = *(const bf16x8*)(cur + bfo + ni * 32 * 40);
        __builtin_amdgcn_sched_barrier(0);
        if (kt < 31) {
#pragma unroll
            for (int i = 0; i < MI; ++i) *(u32x4*)(nxt + wofs + i * 64 * 40) = ra[i];
#pragma unroll
            for (int i = 0; i < 2; ++i) *(u32x4*)(nxt + AST + wofs + i * 64 * 40) = rb[i];
            if (kt < 30) {
#pragma unroll
                for (int i = 0; i < MI; ++i) ra[i] = *(const u32x4*)(ag + (size_t)i * 64 * 1024 + (kt + 2) * 32);
#pragma unroll
                for (int i = 0; i < 2; ++i) rb[i] = *(const u32x4*)(bg + (size_t)i * 64 * 1024 + (kt + 2) * 32);
            }
        }
#pragma unroll
        for (int mi = 0; mi < MI; ++mi) a1[mi] = *(const bf16x8*)(cur + afo + mi * 32 * 40 + 16);
#pragma unroll
        for (int ni = 0; ni < 2; ++ni) b1[ni] = *(const bf16x8*)(cur + bfo + ni * 32 * 40 + 16);
        __builtin_amdgcn_sched_barrier(0);
#pragma unroll
        for (int mi = 0; mi < MI; ++mi) { acc[mi][0] = MFMA32(a0[mi], b0[0], acc[mi][0]); acc[mi][1] = MFMA32(a0[mi], b0[1], acc[mi][1]); }
#pragma unroll
        for (int mi = 0; mi < MI; ++mi) { acc[mi][0] = MFMA32(a1[mi], b1[0], acc[mi][0]); acc[mi][1] = MFMA32(a1[mi], b1[1], acc[mi][1]); }
        __syncthreads();
    }
}

__device__ void p1_gemm(const Params& p, unsigned char* smem) {
    for (int tile_ = blockIdx.x; tile_ < 136 * 32 * REP1; tile_ += gridDim.x) {
        int tid = threadIdx.x; asm volatile("" : "+v"(tid));
        const int tile = tile_ % (136 * 32);
        int mt = tile >> 5, nt = tile & 31;
        if (tile < 4096 && (gridDim.x & 511) == 0) {
            const int rnd = tile >> 9, b = tile & 511, x = b & 7, idx = b >> 3;
            mt = rnd * 16 + 4 * (x >> 1) + (idx >> 4); nt = 16 * (x & 1) + (idx & 15);
        }
        f32x16 acc[4][2];
        gemm_core<4>(p.H + (size_t)mt * 256 * 1024, p.WtIn + (size_t)nt * 128 * 1024, (u16*)smem, acc, tid);
        __syncthreads();
        p1_epilogue<4>(p, acc, mt, nt, (tid >> 6) >> 1, (tid >> 6) & 1, tid & 63, (float*)smem + (tid >> 6) * (32 * 68));
    }
    {
        int tid = threadIdx.x; asm volatile("" : "+v"(tid));
        int* s_item = (int*)(smem + 73728);
        float* tile0 = (float*)smem; float* tile1 = tile0 + 64 * 65;
        for (;;) {
            __syncthreads();
            if (tid == 0) *s_item = (int)atomicAdd(p.ctr + 8 * 32, 1u);
            __syncthreads();
            const int j = __builtin_amdgcn_readfirstlane(*s_item);
            if (j >= 4096) break;
            if (j < 2048) {
                const TJob j0 = tjob(p, 1280 + 2 * j), j1 = tjob(p, 1280 + 2 * j + 1);
                f32x4 v0[4], v1[4];
                tr_load(j0, v0, tid); tr_load(j1, v1, tid);
                tr_put(v0, tile0, tid); tr_put(v1, tile1, tid);
                __syncthreads();
                tr_store(j0, tile0, tid); tr_store(j1, tile1, tid);
            } else {
                const size_t base = (size_t)(j - 2048) * 2048;
                f32x4 v[8];
#pragma unroll
                for (int q = 0; q < 8; ++q) v[q] = __builtin_nontemporal_load((const f32x4*)(p.cache_k + (base + tid + 256 * q) * 4));
#pragma unroll
                for (int q = 0; q < 8; ++q) {
                    const size_t i = base + tid + 256 * q, row = i >> 7; const int c4 = (int)(i & 127), sb = (int)(row >> 10), t = (int)(row & 1023);
                    u32x2 w; w.x = pk2(v[q].x, v[q].y); w.y = pk2(v[q].z, v[q].w);
                    *(u32x2*)(p.SK + ((size_t)(sb * 4 + (c4 >> 5)) * 17 + (t >> 6)) * 8192 + (t & 63) * 128 + (c4 & 31) * 4) = w;
                }
            }
        }
    }
}

constexpr int KV_STAGE = 2 * 128 * 72;
__device__ void attn_unit(const Params& p, unsigned char* smem, const u16* __restrict__ qptr, const u16* __restrict__ kptr, const u16* __restrict__ vtptr,
                          int ntiles, int tok0, int head) {
    u16* sKV = (u16*)smem;
    int tid = threadIdx.x; asm volatile("" : "+v"(tid)); const int lane = tid & 63, wid = tid >> 6, r = lane & 31, h = lane >> 5, c = wid & 1, rg = wid >> 1;
    bf16x8 qf[4];
#pragma unroll
    for (int ks = 0; ks < 4; ++ks) qf[ks] = *(const bf16x8*)(qptr + (size_t)(32 * rg + r) * 512 + c * 64 + 16 * ks + 8 * h);
    f32x16 O[4];
#pragma unroll
    for (int i = 0; i < 4; ++i) O[i] = zero16();
    float m = -1e30f, l = 0.f;
    const int kkey = tid >> 4, kcc = tid & 15;
    const int vdv = tid >> 3, vch = tid & 7;
    const u16* kg = kptr + tid * 8;
    const u16* vg = vtptr + tid * 8;
    const int klo = ((kcc >> 3) * 64 + kkey) * 72 + (kcc & 7) * 8;
    const int vlo = 128 * 72 + vdv * 72 + vch * 8;
    const int kfo = (c * 64 + r) * 72 + 8 * h;
    const int vfo = 128 * 72 + r * 72 + 8 * h;
    u32x4 rk[4], rv[4];
#pragma unroll
    for (int i = 0; i < 4; ++i) { rk[i] = *(const u32x4*)(kg + i * 2048); rv[i] = *(const u32x4*)(vg + i * 2048); }
    __syncthreads();
#pragma unroll
    for (int i = 0; i < 4; ++i) { *(u32x4*)(sKV + klo + i * 16 * 72) = rk[i]; *(u32x4*)(sKV + vlo + i * 32 * 72) = rv[i]; }
    if (ntiles > 1) {
#pragma unroll
        for (int i = 0; i < 4; ++i) { rk[i] = *(const u32x4*)(kg + 8192 + i * 2048); rv[i] = *(const u32x4*)(vg + 8192 + i * 2048); }
    }
    __syncthreads();
    for (int kt = 0; kt < ntiles; ++kt) {
        const u16* cur = sKV + (kt & 1) * KV_STAGE;
        u16* nxt = sKV + ((kt & 1) ^ 1) * KV_STAGE;
        bf16x8 kf[2][4];
#pragma unroll
        for (int ks = 0; ks < 4; ++ks) { kf[0][ks] = *(const bf16x8*)(cur + kfo + 16 * ks); kf[1][ks] = *(const bf16x8*)(cur + kfo + 32 * 72 + 16 * ks); }
        __builtin_amdgcn_sched_barrier(0);
        f32x16 S0 = zero16(), S1 = zero16();
#pragma unroll
        for (int ks = 0; ks < 4; ++ks) { S0 = MFMA32(kf[0][ks], qf[ks], S0); S1 = MFMA32(kf[1][ks], qf[ks], S1); __builtin_amdgcn_sched_barrier(0); }
        bf16x8 va[4][2];
#pragma unroll
        for (int d = 0; d < 4; ++d)
#pragma unroll
            for (int q = 0; q < 2; ++q) va[d][q] = *(const bf16x8*)(cur + vfo + d * 32 * 72 + 16 * q);
        if (kt + 1 < ntiles) {
#pragma unroll
            for (int i = 0; i < 4; ++i) { *(u32x4*)(nxt + klo + i * 16 * 72) = rk[i]; *(u32x4*)(nxt + vlo + i * 32 * 72) = rv[i]; }
            if (kt + 2 < ntiles) {
#pragma unroll
                for (int i = 0; i < 4; ++i) { rk[i] = *(const u32x4*)(kg + (size_t)(kt + 2) * 8192 + i * 2048); rv[i] = *(const u32x4*)(vg + (size_t)(kt + 2) * 8192 + i * 2048); }
            }
        }
        __builtin_amdgcn_sched_barrier(0);
        float mt = fmaxf(S0[0], S1[0]);
#pragma unroll
        for (int i = 1; i < 16; ++i) mt = fmaxf(mt, fmaxf(S0[i], S1[i]));
        mt = xhalf_max(mt);
        if (__any(mt > m)) {
            const float mn = fmaxf(m, mt), al = __builtin_amdgcn_exp2f(m - mn);
            m = mn; l *= al;
#pragma unroll
            for (int d = 0; d < 4; ++d)
#pragma unroll
                for (int i = 0; i < 16; ++i) O[d][i] *= al;
        }
        const f32x2 m2 = {m, m};
        f32x2 l2 = {0.f, 0.f};
        u32x4 pw[4];
#pragma unroll
        for (int j = 0; j < 8; ++j) {
            f32x2 x0 = {S0[2 * j], S0[2 * j + 1]};
            x0 = x0 - m2;
            f32x2 e0; e0.x = __builtin_amdgcn_exp2f(x0.x); e0.y = __builtin_amdgcn_exp2f(x0.y);
            l2 = l2 + e0;
            pw[j >> 2][j & 3] = pk2(e0.x, e0.y);
        }
        const bf16x8 p00 = __builtin_bit_cast(bf16x8, pw[0]), p01 = __builtin_bit_cast(bf16x8, pw[1]);
        bf16x8 vb[4][2];
#pragma unroll
        for (int d = 0; d < 4; ++d)
#pragma unroll
            for (int q = 0; q < 2; ++q) vb[d][q] = *(const bf16x8*)(cur + vfo + d * 32 * 72 + 32 + 16 * q);
#pragma unroll
        for (int j = 0; j < 8; ++j) {
            O[j & 3] = MFMA32(va[j & 3][j >> 2], (j >> 2) ? p01 : p00, O[j & 3]);
            f32x2 x1 = {S1[2 * j], S1[2 * j + 1]};
            x1 = x1 - m2;
            f32x2 e1; e1.x = __builtin_amdgcn_exp2f(x1.x); e1.y = __builtin_amdgcn_exp2f(x1.y);
            l2 = l2 + e1;
            pw[2 + (j >> 2)][j & 3] = pk2(e1.x, e1.y);
        }
        l += l2.x + l2.y;
        const bf16x8 p10 = __builtin_bit_cast(bf16x8, pw[2]), p11 = __builtin_bit_cast(bf16x8, pw[3]);
#pragma unroll
        for (int j = 0; j < 8; ++j) O[j & 3] = MFMA32(vb[j & 3][j >> 2], (j >> 2) ? p11 : p10, O[j & 3]);
        __syncthreads();
    }
    const float inv = 1.f / xhalf_sum(l);
    const float lam = p.misc[0];
    float* ex = (float*)smem + rg * 4096;
    if (c == 1) {
        const float sc = inv * lam;
#pragma unroll
        for (int d = 0; d < 4; ++d)
#pragma unroll
            for (int i = 0; i < 16; ++i) ex[(d * 16 + i) * 64 + lane] = O[d][i] * sc;
    }
    __syncthreads();
    if (c == 0) {
        float ss = 0.f;
#pragma unroll
        for (int d = 0; d < 4; ++d)
#pragma unroll
            for (int i = 0; i < 16; ++i) { const float v = O[d][i] * inv - ex[(d * 16 + i) * 64 + lane]; O[d][i] = v; ss += v * v; }
        ss += __shfl_xor(ss, 32);
        const float rstd = rsqrtf(ss * (1.f / 128.f) + EPS) * 0.8f;
        const size_t tok = (size_t)(tok0 + 32 * rg + r);
#pragma unroll
        for (int d = 0; d < 4; ++d)
#pragma unroll
            for (int g = 0; g < 4; ++g) {
                const int dv0 = 32 * d + 8 * g + 4 * h;
                const u32x2 gt = *(const u32x2*)(p.DG + tok * 512 + head * 128 + dv0);
                const f32x4 gn = *(const f32x4*)(p.diff_norm_g + dv0);
                u32x2 w;
                w.x = pk2(O[d][4 * g + 0] * rstd * gn.x * bf2f(gt.x & 0xffffu), O[d][4 * g + 1] * rstd * gn.y * bf2f(gt.x >> 16));
                w.y = pk2(O[d][4 * g + 2] * rstd * gn.z * bf2f(gt.y & 0xffffu), O[d][4 * g + 3] * rstd * gn.w * bf2f(gt.y >> 16));
                *(u32x2*)(p.MIX + tok * 1024 + 512 + head * 128 + dv0) = w;
            }
    }
}

__device__ void ret_scan_item(const Params& p, int seqi, int hd) {
    int tid = threadIdx.x; asm volatile("" : "+v"(tid)); const int lane = tid & 63, wid = tid >> 6, r = lane & 31, h = lane >> 5, dvb = wid >> 1, dkb = wid & 1;
    const bool samp = seqi >= 4; const int sb = seqi - 4;
    const size_t tbase = samp ? TR_S_OFF + (size_t)(sb * 8 + hd) * 4096 : ((size_t)(seqi * 8 + hd) * 128) * 4096;
    const u16* vt = p.RVt + tbase + (size_t)(32 * dvb + r) * 64 + 8 * h;
    const u16* kt = p.RKtd + tbase + (size_t)(32 * dkb + r) * 64 + 8 * h;
    const int nch = samp ? 1 : 128;
    u16* sprev = p.SPREV + (size_t)(samp ? 4096 + sb * 8 + hd : (seqi * 8 + hd) * 128) * 4096;
    float* so = samp ? p.out + O_SS + (size_t)(sb * 8 + hd) * 4096 : p.out + O_SP + (size_t)(seqi * 8 + hd) * 4096;
    const int dk = 32 * dkb + r;
    f32x16 S = zero16();
    if (samp) {
        const float* si = p.state_ret + (size_t)(sb * 8 + hd) * 4096 + (size_t)dk * 64 + 32 * dvb + 4 * h;
#pragma unroll
        for (int g = 0; g < 4; ++g) { const f32x4 v = *(const f32x4*)(si + 8 * g); S[4 * g] = v.x; S[4 * g + 1] = v.y; S[4 * g + 2] = v.z; S[4 * g + 3] = v.w; }
    }
    const float g64 = exp2f(log2_gamma(hd) * 64.f);
    bf16x8 an[4], bn[4];
#pragma unroll
    for (int ks = 0; ks < 4; ++ks) { an[ks] = *(const bf16x8*)(vt + 16 * ks); bn[ks] = *(const bf16x8*)(kt + 16 * ks); }
    for (int c = 0; c < nch; ++c) {
        bf16x8 a[4], b[4];
#pragma unroll
        for (int ks = 0; ks < 4; ++ks) { a[ks] = an[ks]; b[ks] = bn[ks]; }
        if (c + 1 < nch) {
#pragma unroll
            for (int ks = 0; ks < 4; ++ks) { an[ks] = *(const bf16x8*)(vt + (size_t)(c + 1) * 4096 + 16 * ks); bn[ks] = *(const bf16x8*)(kt + (size_t)(c + 1) * 4096 + 16 * ks); }
        }
#pragma unroll
        for (int i = 0; i < 16; ++i) sprev[(size_t)c * 4096 + (32 * dvb + crow(i, h)) * 64 + dk] = f2bf(S[i]);
        f32x16 KV = zero16();
#pragma unroll
        for (int ks = 0; ks < 4; ++ks) KV = MFMA32(a[ks], b[ks], KV);
#pragma unroll
        for (int i = 0; i < 16; ++i) S[i] = g64 * S[i] + KV[i];
    }
#pragma unroll
    for (int g = 0; g < 4; ++g) { f32x4 v = {S[4 * g], S[4 * g + 1], S[4 * g + 2], S[4 * g + 3]}; *(f32x4*)(so + (size_t)dk * 64 + 32 * dvb + 4 * h + 8 * g) = v; }
    asm volatile("s_waitcnt vmcnt(0)" ::: "memory");
    __syncthreads();
    if (tid == 0) {
        __builtin_amdgcn_fence(__ATOMIC_RELEASE, "agent");
        asm volatile("s_waitcnt vmcnt(0)" ::: "memory");
        __hip_atomic_fetch_add(p.done + seqi * 2 + (hd >> 2), 1u, __ATOMIC_RELAXED, __HIP_MEMORY_SCOPE_AGENT);
    }
}

__device__ void p3_tile(const Params& p, int tile, int hh) {
    int tid = threadIdx.x;
    asm volatile("" : "+v"(tid));
    const int lane = tid & 63, wid = tid >> 6, r = lane & 31, h = lane >> 5;
    int hf, tokc, unit0, ustride; size_t vtb, L, pos0;
    if (tile < 1024) { const int b = tile >> 8, c = (tile >> 1) & 127; hf = tile & 1; tokc = b * 8192 + c * 64; unit0 = (b * 8) * 128 + c; ustride = 128; vtb = ((size_t)(b * 8) * 128 + c) * 4096; L = 128 * 4096; pos0 = 0; }
    else { const int k = tile - 1024, sb = k >> 1; hf = k & 1; tokc = TP + sb * 64; unit0 = 4096 + sb * 8; ustride = 1; vtb = TR_S_OFF + (size_t)(sb * 8) * 4096; L = 4096; pos0 = 0; }
    const int tok0 = tokc + 32 * hf;
    const int qi = 32 * hf + r;
    {
        const int hd = 4 * hh + wid;
        const float lg = log2_gamma(hd);
        bf16x8 qf[4];
#pragma unroll
        for (int ks = 0; ks < 4; ++ks) qf[ks] = *(const bf16x8*)(p.RQ + (size_t)(tok0 + r) * 512 + hd * 64 + 16 * ks + 8 * h);
        __builtin_amdgcn_sched_barrier(0);
        f32x16 S0 = zero16(), S1 = zero16();
#pragma unroll
        for (int ks = 0; ks < 4; ++ks) S0 = MFMA32(*(const bf16x8*)(p.RK + (size_t)(tokc + r) * 512 + hd * 64 + 16 * ks + 8 * h), qf[ks], S0);
        if (hf) {
#pragma unroll
            for (int ks = 0; ks < 4; ++ks) S1 = MFMA32(*(const bf16x8*)(p.RK + (size_t)(tokc + 32 + r) * 512 + hd * 64 + 16 * ks + 8 * h), qf[ks], S1);
        }
#pragma unroll
        for (int i = 0; i < 16; ++i) {
            const int k0 = crow(i, h), k1 = 32 + k0;
            S0[i] = qi >= k0 ? S0[i] * __builtin_amdgcn_exp2f(lg * (float)(qi - k0)) : 0.f;
            S1[i] = qi >= k1 ? S1[i] * __builtin_amdgcn_exp2f(lg * (float)(qi - k1)) : 0.f;
        }
        const bf16x8 p00 = pack8<0>(S0), p01 = pack8<1>(S0), p10 = pack8<0>(S1), p11 = pack8<1>(S1);
        __builtin_amdgcn_sched_barrier(0);
        const float qd = __builtin_amdgcn_exp2f(lg * (float)(qi + 1));
        const u16* vt = p.RVt + vtb + (size_t)hd * L + pos0 + 8 * h;
        const u16* sp = p.SPREV + (size_t)(unit0 + hd * ustride) * 4096 + 8 * h;
        float ss = 0.f;
        f32x16 o[2];
#pragma unroll
        for (int d = 0; d < 2; ++d) {
            f32x16 in = zero16(), cr = zero16();
            const u16* vr = vt + (size_t)(32 * d + r) * 64;
            in = MFMA32(*(const bf16x8*)(vr), p00, in);
            in = MFMA32(*(const bf16x8*)(vr + 16), p01, in);
            if (hf) { in = MFMA32(*(const bf16x8*)(vr + 32), p10, in); in = MFMA32(*(const bf16x8*)(vr + 48), p11, in); }
#pragma unroll
            for (int ks = 0; ks < 4; ++ks) cr = MFMA32(*(const bf16x8*)(sp + (32 * d + r) * 64 + 16 * ks), qf[ks], cr);
#pragma unroll
            for (int i = 0; i < 16; ++i) { const float v = in[i] + cr[i] * qd; o[d][i] = v; ss += v * v; }
            __builtin_amdgcn_sched_barrier(0);
        }
        ss += __shfl_xor(ss, 32);
        const float rstd = rsqrtf(ss * (1.f / 64.f) + EPS);
#pragma unroll
        for (int d = 0; d < 2; ++d)
#pragma unroll
            for (int g = 0; g < 4; ++g) {
                const int dv0 = 32 * d + 8 * g + 4 * h;
                const u32x2 gt = *(const u32x2*)(p.RG + (size_t)(tok0 + r) * 512 + hd * 64 + dv0);
                const f32x4 gn = *(const f32x4*)(p.ret_norm_g + hd * 64 + dv0);
                u32x2 w;
                w.x = pk2(o[d][4 * g + 0] * rstd * gn.x * bf2f(gt.x & 0xffffu), o[d][4 * g + 1] * rstd * gn.y * bf2f(gt.x >> 16));
                w.y = pk2(o[d][4 * g + 2] * rstd * gn.z * bf2f(gt.y & 0xffffu), o[d][4 * g + 3] * rstd * gn.w * bf2f(gt.y >> 16));
                *(u32x2*)(p.MIX + (size_t)(tok0 + r) * 1024 + hd * 64 + dv0) = w;
            }
    }
}


constexpr int XQ_ITEMS = 4 + 32 + 256 + 16 + 256 + 16;
DI void wait_done(const Params& p, int idx, int tid) {
    if (tid == 0) {
        unsigned sp = 0;
        while (__hip_atomic_load(p.done + idx, __ATOMIC_RELAXED, __HIP_MEMORY_SCOPE_AGENT) < 4u) { __builtin_amdgcn_s_sleep(2); if (++sp > (1u << 22)) break; }
        __builtin_amdgcn_fence(__ATOMIC_ACQUIRE, "agent");
        asm volatile("s_waitcnt vmcnt(0)" ::: "memory");
    }
    __syncthreads();
}
__device__ void p2_mix(const Params& p, unsigned char* smem) {
    int* s_item = (int*)(smem + 73728);
    int tid = threadIdx.x; asm volatile("" : "+v"(tid));
    const int xcc = (int)(xb_xcc_id() & 7u);
    for (int q = 0; q < 8; ++q) {
        const int x = (xcc + q) & 7;
        while (true) {
            __syncthreads();
            if (tid == 0) *s_item = (int)atomicAdd(p.ctr + x * 32, 1u);
            __syncthreads();
            const int it = __builtin_amdgcn_readfirstlane(*s_item);
            if (it >= XQ_ITEMS) break;
            int kind, arg;
            if (it < 4) { kind = 0; arg = it; }
            else if (it < 36) { kind = 4; arg = it - 4; }
            else if (it < 228) { kind = 1; arg = it - 36; }
            else if (it < 244) { kind = 2; arg = it - 228; }
            else if (it < 564) { const int g = (it - 244) / 10, e = (it - 244) % 10; if (e < 2) { kind = 1; arg = 192 + 2 * g + e; } else { kind = 3; arg = 8 * g + (e - 2); } }
            else { kind = 3; arg = 256 + (it - 564); }
            if (kind == 0) { const int s = 4 * x + arg; ret_scan_item(p, s >> 3, s & 7); }
            else if (kind == 4) { const int k = 32 * x + arg; ret_scan_item(p, 4 + (k >> 3), k & 7); }
            else if (kind == 1) {
                const int k = arg, j = 127 - (k >> 1), bh = 2 * x + (k & 1), b = bh >> 2, hh = bh & 3;
                const int tok0 = b * 8192 + j * 64;
                attn_unit(p, smem, p.DQ + (size_t)tok0 * 512 + hh * 128, p.DKp + (size_t)(bh * 128) * 8192, p.DVtp + (size_t)(bh * 128) * 8192, j + 1, tok0, hh);
            } else if (kind == 2) {
                const int k = 16 * x + arg, sb = k >> 2, hh = k & 3;
                const int tok0 = TP + sb * 64;
                attn_unit(p, smem, p.DQ + (size_t)tok0 * 512 + hh * 128, p.SK + (size_t)(k * 17) * 8192, p.SVt + (size_t)(k * 17) * 8192, 17, tok0, hh);
            } else if (arg < 256) {
                const int b = x >> 1, hh = x & 1;
                wait_done(p, b * 2 + hh, tid);
                p3_tile(p, b * 256 + arg, hh);
            } else {
                const int k = arg - 256, sb = 4 * x + (k >> 2), hf = (k >> 1) & 1, hh = k & 1;
                wait_done(p, (4 + sb) * 2 + hh, tid);
                p3_tile(p, 1024 + sb * 2 + hf, hh);
            }
        }
    }
}

template <int MI> DI void p5_tile(const Params& p, unsigned char* smem, int row0, int nt, int tid) {
    f32x16 acc[MI][2];
    gemm_core<MI>(p.MIX + (size_t)row0 * 1024, p.WtOut + (size_t)nt * 128 * 1024, (u16*)smem, acc, tid);
    const int lane = tid & 63, wid = tid >> 6, r = lane & 31, h = lane >> 5, wm = wid >> 1, wn = wid & 1;
    float* red = (float*)smem;
    __syncthreads();
#pragma unroll
    for (int mi = 0; mi < MI; ++mi) {
        const int rl = wm * 32 * MI + mi * 32, tok0 = row0 + rl;
        const float* xb = (tok0 < TP ? p.x_p + (size_t)tok0 * D : p.x_s + (size_t)(tok0 - TP) * D) + nt * 128 + wn * 64 + r;
        float* yb = p.out + O_Y + (size_t)tok0 * D + nt * 128 + wn * 64 + r;
#pragma unroll
        for (int i = 0; i < 16; ++i) {
            const size_t ro = (size_t)crow(i, h) * D;
            const float v0 = acc[mi][0][i] + __builtin_nontemporal_load(xb + ro), v1 = acc[mi][1][i] + __builtin_nontemporal_load(xb + ro + 32);
            yb[ro] = v0; yb[ro + 32] = v1;
            float s = v0 * v0 + v1 * v1;
#pragma unroll
            for (int o = 1; o <= 16; o <<= 1) s += __shfl_xor(s, o);
            if (r == 0) red[wn * 64 * MI + rl + crow(i, h)] = s;
        }
    }
    __syncthreads();
    if (tid < 64 * MI) unsafeAtomicAdd(p.rowss + row0 + tid, red[tid] + red[64 * MI + tid]);
}
__device__ void p5_gemm(const Params& p, unsigned char* smem) {
    for (int tile_ = blockIdx.x; tile_ < (1024 + 256) * REP5; tile_ += gridDim.x) {
        int tid = threadIdx.x; asm volatile("" : "+v"(tid));
        const int tile = tile_ % (1024 + 256);
        if (tile < 1024) p5_tile<4>(p, smem, (tile >> 3) * 256, tile & 7, tid);
        else { const int t = tile - 1024; p5_tile<1>(p, smem, TP + (t >> 3) * 64, t & 7, tid); }
    }
}

__device__ void p6_norm(const Params& p) {
    const int tid = threadIdx.x, lane = tid & 63, wid = tid >> 6;
    f32x4 g[4];
#pragma unroll
    for (int i = 0; i < 4; ++i) g[i] = *(const f32x4*)(p.final_g + (lane + 64 * i) * 4);
    for (int row = (blockIdx.x * 4 + wid) * 2; row < T; row += gridDim.x * 8) {
        f32x4 v[2][4];
#pragma unroll
        for (int q = 0; q < 2; ++q)
#pragma unroll
            for (int i = 0; i < 4; ++i) v[q][i] = __builtin_nontemporal_load((const f32x4*)(p.out + O_Y + (size_t)(row + q) * D + (lane + 64 * i) * 4));
#pragma unroll
        for (int q = 0; q < 2; ++q) {
            const float rs = rsqrtf(p.rowss[row + q] * (1.f / 1024.f) + EPS);
#pragma unroll
            for (int i = 0; i < 4; ++i) { f32x4 o = v[q][i] * g[i] * rs; __builtin_nontemporal_store(o, (f32x4*)(p.out + O_Y + (size_t)(row + q) * D + (lane + 64 * i) * 4)); }
        }
    }
}

#define SMEM_DECL __shared__ __attribute__((aligned(16))) unsigned char smem[LDS_BYTES]
#if MULTI_LAUNCH
__global__ void __launch_bounds__(NTHREADS, 2) k_p0(Params p) { SMEM_DECL; p0_prep(p, smem); }
__global__ void __launch_bounds__(NTHREADS, 2) k_p1(Params p) { SMEM_DECL; p1_gemm(p, smem); }
__global__ void __launch_bounds__(NTHREADS, 2) k_p2(Params p) { SMEM_DECL; p2_mix(p, smem); }
__global__ void __launch_bounds__(NTHREADS, 2) k_p5(Params p) { SMEM_DECL; p5_gemm(p, smem); }
__global__ void __launch_bounds__(NTHREADS, 2) k_p6(Params p) { p6_norm(p); }
#else
__global__ void __launch_bounds__(NTHREADS, 2) fwd_megakernel(Params p) {
    SMEM_DECL;
    __shared__ uint4 xb_words;
    cg::grid_group grid = cg::this_grid();
    if (p.never) grid.sync();
    if (threadIdx.x == 0) xb_words = make_uint4(0u, 0u, 0u, 0u);
    __syncthreads();
    const XcdBarrier xb = xcd_barrier_post(p.bar, (volatile LAS unsigned*)&xb_words);
#pragma nounroll
    for (int rep = 0; rep < REP0; ++rep) p0_prep(p, smem);
    xcd_barrier(xb);
    p1_gemm(p, smem);
    xcd_barrier(xb);
    p2_mix(p, smem);
    xcd_barrier(xb);
    p5_gemm(p, smem);
    xcd_barrier(xb);
    p6_norm(p);
}
#endif

extern "C" void kernel_launch(void* const* d_in, const int* in_sizes, int n_in, void* d_out, int out_size, void* d_ws, size_t ws_size, hipStream_t stream) {
    Params p{};
    p.x_p = (const float*)d_in[0]; p.x_s = (const float*)d_in[1]; p.cache_k = (const float*)d_in[2]; p.cache_v = (const float*)d_in[3]; p.state_ret = (const float*)d_in[4];
    p.norm_g = (const float*)d_in[5]; p.w_in = (const float*)d_in[6]; p.w_out = (const float*)d_in[7]; p.ret_norm_g = (const float*)d_in[8]; p.diff_norm_g = (const float*)d_in[9];
    p.lam_q1 = (const float*)d_in[10]; p.lam_k1 = (const float*)d_in[11]; p.lam_q2 = (const float*)d_in[12]; p.lam_k2 = (const float*)d_in[13]; p.final_g = (const float*)d_in[14];
    p.out = (float*)d_out;
    unsigned char* w = (unsigned char*)d_ws; size_t off = 0;
    auto take = [&](size_t bytes) { unsigned char* r = w + off; off += (bytes + 255) & ~(size_t)255; return r; };
    const size_t HALF = (size_t)T * 512 * 2;
    p.H = (u16*)take(2 * HALF);
    p.MIX = p.H; p.SPREV = (u16*)take(HALF);
    p.WtIn = (u16*)take((size_t)4096 * 1024 * 2); p.WtOut = (u16*)take((size_t)1024 * 1024 * 2);
    p.RQ = (u16*)take(HALF); p.RK = (u16*)take(HALF); p.RKtd = (u16*)take(HALF); p.RVt = (u16*)take(HALF); p.RG = (u16*)take(HALF); p.DQ = (u16*)take(HALF); p.DG = (u16*)take(HALF);
    p.cosR = (float*)take(8192 * 32 * 4); p.sinR = (float*)take(8192 * 32 * 4); p.cosD = (float*)take(8192 * 8 * 4); p.sinD = (float*)take(8192 * 8 * 4);
    p.misc = (float*)take(256); p.ctr = (unsigned*)take(2048); p.done = (unsigned*)take(512); p.rowss = (float*)take((size_t)T * 4); p.bar = (unsigned*)take(XCD_BAR_WORDS * 4);
    unsigned char* yo = (unsigned char*)d_out; size_t yoff = 0;
    auto takey = [&](size_t bytes) { unsigned char* r = yo + yoff; yoff += (bytes + 255) & ~(size_t)255; return r; };
    p.DKp = (u16*)takey((size_t)TP * 512 * 2); p.SK = (u16*)takey((size_t)32 * SKL * 512 * 2); p.DVtp = (u16*)takey((size_t)2048 * 8192 * 2); p.SVt = (u16*)takey((size_t)16384 * SKL * 2);
    if (off > ws_size || yoff > (size_t)35651584 * 4) { fprintf(stderr, "workspace too small: need %zu have %zu\n", off, ws_size); return; }
#if MULTI_LAUNCH
    static int gb = 0;
    if (!gb) { int dev = 0, cus = 0; hipGetDevice(&dev); hipDeviceGetAttribute(&cus, hipDeviceAttributeMultiprocessorCount, dev); gb = cus * 2; }
    k_p0<<<gb, NTHREADS, 0, stream>>>(p); k_p1<<<gb, NTHREADS, 0, stream>>>(p); k_p2<<<gb, NTHREADS, 0, stream>>>(p); k_p5<<<gb, NTHREADS, 0, stream>>>(p); k_p6<<<gb, NTHREADS, 0, stream>>>(p);
#else
    static int grid_blocks = 0;
    if (!grid_blocks) {
        int dev = 0, cus = 0, per_cu = 0;
        hipGetDevice(&dev); hipDeviceGetAttribute(&cus, hipDeviceAttributeMultiprocessorCount, dev);
        hipOccupancyMaxActiveBlocksPerMultiprocessor(&per_cu, fwd_megakernel, NTHREADS, 0);
        if (per_cu > 2) per_cu = 2;
        if (per_cu < 1) per_cu = 1;
        grid_blocks = cus * per_cu;
    }
    hipMemsetAsync(p.bar, 0, XCD_BAR_WORDS * 4, stream);
    void* args[] = {&p};
    hipError_t e = hipLaunchCooperativeKernel((void*)fwd_megakernel, dim3(grid_blocks), dim3(NTHREADS), args, 0, stream);
    if (e != hipSuccess) fprintf(stderr, "cooperative launch failed: %s (grid %d)\n", hipGetErrorString(e), grid_blocks);
#endif
}
```

```cpp
#include <hip/hip_runtime.h>
#include <hip/hip_cooperative_groups.h>
#include <cstdio>
#include <cstdint>
namespace cg = cooperative_groups;

#ifndef REP1
#define REP1 1
#endif
#ifndef REP3
#define REP3 1
#endif
#ifndef REP5
#define REP5 1
#endif
#ifndef REP0
#define REP0 1
#endif
#ifndef MULTI_LAUNCH
#define MULTI_LAUNCH 0
#endif

typedef unsigned short u16;
typedef short bf16x8 __attribute__((ext_vector_type(8)));
typedef float f32x4 __attribute__((ext_vector_type(4)));
typedef float f32x2 __attribute__((ext_vector_type(2)));
typedef float f32x16 __attribute__((ext_vector_type(16)));
typedef unsigned u32x4 __attribute__((ext_vector_type(4)));
typedef unsigned u32x2 __attribute__((ext_vector_type(2)));
typedef __bf16 bf16x2_t __attribute__((ext_vector_type(2)));

#define DI __device__ __forceinline__
#define MFMA32(a, b, c) __builtin_amdgcn_mfma_f32_32x32x16_bf16((a), (b), (c), 0, 0, 0)

constexpr int D = 1024, TP = 32768, TS = 2048, T = TP + TS, PAST = 1024, SKL = 1088;
constexpr int NTHREADS = 256;
constexpr int LDS_BYTES = 73728 + 64;
constexpr float EPS = 1e-6f;
constexpr float QSCALE = 0.125f * 1.4426950408889634f;
constexpr size_t O_Y = 0, O_SP = 35651584, O_SS = 35782656, O_KP = 36831232, O_VP = 53608448, O_KS = 70385664, O_VS = 71434240;
constexpr size_t TR_S_OFF = 16777216;
constexpr int NITEMS = 32 + 2048 + 128 + 256;

struct Params {
    const float *x_p, *x_s, *cache_k, *cache_v, *state_ret, *norm_g, *w_in, *w_out, *ret_norm_g, *diff_norm_g, *lam_q1, *lam_k1, *lam_q2, *lam_k2, *final_g;
    float* out;
    u16 *H, *WtIn, *WtOut, *RQ, *RK, *RKtd, *RVt, *RG, *DQ, *DKp, *SK, *DVtp, *SVt, *DG, *MIX, *SPREV;
    float *cosR, *sinR, *cosD, *sinD, *misc, *rowss;
    unsigned* ctr; unsigned* bar; unsigned* done;
    int never; int pad_;
};

DI unsigned pk2(float lo, float hi) { f32x2 v = {lo, hi}; bf16x2_t b = __builtin_convertvector(v, bf16x2_t); return __builtin_bit_cast(unsigned, b); }
DI u16 f2bf(float x) { return (u16)(pk2(x, 0.f) & 0xffffu); }
DI float bf2f(unsigned v) { return __uint_as_float(v << 16); }
DI int crow(int i, int h) { return (i & 3) + 8 * (i >> 2) + 4 * h; }
DI float silu(float v) { return v / (1.f + __expf(-v)); }
DI float log2_gamma(int hd) {
    const float x = exp2f(-5.f - (float)hd);
    float s = x * (1.f + x * (0.5f + x * (1.f / 3.f + x * (0.25f + x * (0.2f + x * (1.f / 6.f))))));
    return -s * 1.4426950408889634f;
}
template <int S> DI bf16x8 pack8(const f32x16& x) {
    u32x4 p;
    p.x = pk2(x[8 * S + 0], x[8 * S + 1]); p.y = pk2(x[8 * S + 2], x[8 * S + 3]);
    p.z = pk2(x[8 * S + 4], x[8 * S + 5]); p.w = pk2(x[8 * S + 6], x[8 * S + 7]);
    return __builtin_bit_cast(bf16x8, p);
}
DI float xhalf_max(float v) { auto r = __builtin_amdgcn_permlane32_swap(__float_as_uint(v), __float_as_uint(v), false, false); return fmaxf(__uint_as_float(r[0]), __uint_as_float(r[1])); }
DI float xhalf_sum(float v) { auto r = __builtin_amdgcn_permlane32_swap(__float_as_uint(v), __float_as_uint(v), false, false); return __uint_as_float(r[0]) + __uint_as_float(r[1]); }
DI f32x16 zero16() { f32x16 z; for (int i = 0; i < 16; ++i) z[i] = 0.f; return z; }


#define XB_TMO      128
#define XB_XCNT(j)  (256  + 64 * (j))
#define XB_XSUB(j)  (1280 + 64 * (j))
#define XB_XGEN(j)  (2304 + 64 * (j))
#define XB_TOP      3328
#define XB_TOPGEN   3392
#define XCD_BAR_WORDS 3456
#define XB_SPIN_CAP (1u << 20)
#define LAS __attribute__((address_space(3)))
DI unsigned xb_ld(unsigned* p)              { return __hip_atomic_load(p, __ATOMIC_RELAXED, __HIP_MEMORY_SCOPE_AGENT); }
DI unsigned xb_add(unsigned* p, unsigned v) { return __hip_atomic_fetch_add(p, v, __ATOMIC_RELAXED, __HIP_MEMORY_SCOPE_AGENT); }
DI unsigned xb_xcc_id() { return (unsigned)__builtin_amdgcn_s_getreg((3 << 11) | 20) & 0xFu; }
#define XB_SPIN(cond, bar) do { unsigned _sp = 0; while (cond) { __builtin_amdgcn_s_sleep(1); \
    if ((++_sp & 255u) == 0u) { if (xb_ld(&(bar)[XB_TMO])) break; if (_sp > XB_SPIN_CAP) { atomicAdd(&(bar)[XB_TMO], 1u); break; } } } } while (0)
struct XcdBarrier { unsigned* bar; unsigned x; volatile LAS unsigned* st; };
DI XcdBarrier xcd_barrier_post(unsigned* bar, volatile LAS unsigned* st) {
    XcdBarrier b; b.bar = bar; b.x = xb_xcc_id(); b.st = st;
    if (threadIdx.x == 0) (void)xb_add(&bar[XB_XCNT(b.x)], 1u);
    return b;
}
DI void xcd_barrier_complete(unsigned* bar, unsigned x, unsigned& nloc, unsigned& nx) {
    const unsigned G = gridDim.x * gridDim.y * gridDim.z;
    unsigned sum, cnt, mine, sp = 0u;
    for (;;) {
        sum = 0u; cnt = 0u; mine = 0u;
#pragma unroll
        for (unsigned j = 0; j < 16; ++j) { const unsigned c = xb_ld(&bar[XB_XCNT(j)]); sum += c; cnt += (c > 0u) ? 1u : 0u; mine = (j == x) ? c : mine; }
        if (sum == G) break;
        __builtin_amdgcn_s_sleep(1);
        if ((++sp & 255u) == 0u) { if (xb_ld(&bar[XB_TMO])) break; if (sp > XB_SPIN_CAP) { atomicAdd(&bar[XB_TMO], 1u); break; } }
    }
    nloc = mine > 0u ? mine : 1u; nx = cnt > 0u ? cnt : 1u;
}
DI void xcd_barrier(const XcdBarrier& b) {
    asm volatile("s_waitcnt vmcnt(0)" ::: "memory");
    __syncthreads();
    if (threadIdx.x == 0) {
        unsigned* bar = b.bar;
        __builtin_amdgcn_s_waitcnt(0);
        unsigned nloc = b.st[0], nx = b.st[1];
        if (nloc == 0u) { xcd_barrier_complete(bar, b.x, nloc, nx); b.st[0] = nloc; b.st[1] = nx; }
        const unsigned old = xb_add(&bar[XB_XSUB(b.x)], 1u);
        const unsigned gen = old / nloc;
        if (old + 1u == (gen + 1u) * nloc) {
            __builtin_amdgcn_fence(__ATOMIC_RELEASE, "agent");
            asm volatile("s_waitcnt vmcnt(0)" ::: "memory");
            const unsigned og = xb_add(&bar[XB_TOP], 1u);
            const unsigned tg = og / nx;
            if (og + 1u == (tg + 1u) * nx) xb_add(&bar[XB_TOPGEN], 1u);
            else XB_SPIN(xb_ld(&bar[XB_TOPGEN]) == tg, bar);
            __builtin_amdgcn_fence(__ATOMIC_ACQUIRE, "agent");
            xb_add(&bar[XB_XGEN(b.x)], 1u);
            asm volatile("s_waitcnt vmcnt(0)" ::: "memory");
        } else {
            XB_SPIN(xb_ld(&bar[XB_XGEN(b.x)]) == gen, bar);
            __builtin_amdgcn_fence(__ATOMIC_ACQUIRE, "agent");
            asm volatile("s_waitcnt vmcnt(0)" ::: "memory");
        }
    }
    __syncthreads();
}

struct TJob { const float* src; size_t ss; u16* dst; size_t ds; bool perm; };
DI TJob tjob(const Params& p, int t) {
    TJob j;
    if (t < 1024) { const int kt = t >> 6, nt = t & 63;
        j.src = p.w_in + (size_t)kt * 64 * 4096 + nt * 64; j.ss = 4096; j.dst = p.WtIn + (size_t)nt * 64 * 1024 + kt * 64; j.ds = 1024; j.perm = false;
    } else if (t < 1280) { const int q = t - 1024, kt = q >> 4, nt = q & 15;
        j.src = p.w_out + (size_t)kt * 64 * 1024 + nt * 64; j.ss = 1024; j.dst = p.WtOut + (size_t)nt * 64 * 1024 + kt * 64; j.ds = 1024; j.perm = false;
    } else { const int q = t - 1280, sbh = q >> 5, keyt = (q >> 1) & 15, dvt = q & 1, sb = sbh >> 2, hh = sbh & 3;
        j.src = p.cache_v + ((size_t)sb * 1024 + keyt * 64) * 512 + hh * 128 + dvt * 64; j.ss = 512; j.dst = p.SVt + ((size_t)sbh * 17 + keyt) * 8192 + dvt * 64 * 64; j.ds = 64; j.perm = true;
    }
    return j;
}
DI void tr_load(const TJob& j, f32x4 (&v)[4], int tid) {
#pragma unroll
    for (int i = 0; i < 4; ++i) v[i] = __builtin_nontemporal_load((const f32x4*)(j.src + (size_t)((tid >> 4) + 16 * i) * j.ss + (tid & 15) * 4));
}
DI void tr_put(const f32x4 (&v)[4], float* tile, int tid) {
#pragma unroll
    for (int i = 0; i < 4; ++i) { const int r = (tid >> 4) + 16 * i, c4 = (tid & 15) * 4;
        tile[(c4 + 0) * 65 + r] = v[i].x; tile[(c4 + 1) * 65 + r] = v[i].y; tile[(c4 + 2) * 65 + r] = v[i].z; tile[(c4 + 3) * 65 + r] = v[i].w; }
}
DI void tr_store(const TJob& j, const float* tile, int tid) {
#pragma unroll
    for (int i = 0; i < 2; ++i) {
        const int id = tid + 256 * i, c = id >> 3, p0 = (id & 7) * 8;
        float e[8];
#pragma unroll
        for (int jj = 0; jj < 8; ++jj) { const int pos = p0 + jj; const int r = j.perm ? ((pos & ~12) | ((pos & 4) << 1) | ((pos & 8) >> 1)) : pos; e[jj] = tile[c * 65 + r]; }
        u32x4 w; w.x = pk2(e[0], e[1]); w.y = pk2(e[2], e[3]); w.z = pk2(e[4], e[5]); w.w = pk2(e[6], e[7]);
        *(u32x4*)(j.dst + (size_t)c * j.ds + p0) = w;
    }
}

__device__ void p0_prep(const Params& p, unsigned char* smem) {
    int tid = threadIdx.x; asm volatile("" : "+v"(tid)); const int lane = tid & 63, wid = tid >> 6, nb = gridDim.x, bid = blockIdx.x;
    if (bid == 0 && tid == 0) {
        float s1 = 0.f, s2 = 0.f;
        for (int i = 0; i < 64; ++i) { s1 += p.lam_q1[i] * p.lam_k1[i]; s2 += p.lam_q2[i] * p.lam_k2[i]; }
        p.misc[0] = expf(s1) - expf(s2) + 0.2f;
        for (int i = 0; i < 288; ++i) p.ctr[i] = 0u;
        for (int i = 0; i < 128; ++i) p.done[i] = 0u;
    }
    for (int i = bid * 256 + tid; i < T; i += nb * 256) p.rowss[i] = 0.f;
    for (int row = (bid * 4 + wid) * 2; row < T; row += nb * 8) {
        f32x4 v[2][4]; float ss[2] = {0.f, 0.f};
#pragma unroll
        for (int q = 0; q < 2; ++q) { const int rw = row + q; const float* src = rw < TP ? p.x_p + (size_t)rw * D : p.x_s + (size_t)(rw - TP) * D;
#pragma unroll
            for (int i = 0; i < 4; ++i) v[q][i] = __builtin_nontemporal_load((const f32x4*)(src + (lane + 64 * i) * 4)); }
        f32x4 g[4];
#pragma unroll
        for (int i = 0; i < 4; ++i) g[i] = *(const f32x4*)(p.norm_g + (lane + 64 * i) * 4);
#pragma unroll
        for (int q = 0; q < 2; ++q) {
#pragma unroll
            for (int i = 0; i < 4; ++i) ss[q] += v[q][i].x * v[q][i].x + v[q][i].y * v[q][i].y + v[q][i].z * v[q][i].z + v[q][i].w * v[q][i].w;
#pragma unroll
            for (int o = 32; o >= 1; o >>= 1) ss[q] += __shfl_xor(ss[q], o);
            const float rstd = rsqrtf(ss[q] * (1.f / 1024.f) + EPS);
#pragma unroll
            for (int i = 0; i < 4; ++i) {
                u32x2 w; w.x = pk2(v[q][i].x * rstd * g[i].x, v[q][i].y * rstd * g[i].y); w.y = pk2(v[q][i].z * rstd * g[i].z, v[q][i].w * rstd * g[i].w);
                *(u32x2*)(p.H + (size_t)(row + q) * D + (lane + 64 * i) * 4) = w;
            }
        }
    }
    float* tile0 = (float*)smem; float* tile1 = tile0 + 64 * 65;
    for (int t = bid; t < 1280; t += 2 * nb) {
        const bool two = t + nb < 1280;
        const TJob j0 = tjob(p, t), j1 = tjob(p, two ? t + nb : t);
        f32x4 v0[4], v1[4];
        tr_load(j0, v0, tid); if (two) tr_load(j1, v1, tid);
        __syncthreads();
        tr_put(v0, tile0, tid); if (two) tr_put(v1, tile1, tid);
        __syncthreads();
        tr_store(j0, tile0, tid); if (two) tr_store(j1, tile1, tid);
    }
    for (int i = bid * 256 + tid; i < 8192 * 40; i += nb * 256) {
        const int pos = i / 40, f = i % 40;
        const float inv = f < 32 ? exp2f(-13.287712379549449f * (float)f * (1.f / 32.f)) : exp2f(-18.931568569324174f * (float)(f - 32) * (1.f / 8.f));
        const float ang = (float)pos * inv;
        const double rev = (double)ang * 0.15915494309189535; const float fr = (float)(rev - rint(rev));
        const float sn = __builtin_amdgcn_sinf(fr), cs = __builtin_amdgcn_cosf(fr);
        if (f < 32) { p.cosR[pos * 32 + f] = cs; p.sinR[pos * 32 + f] = sn; } else { p.cosD[pos * 8 + f - 32] = cs; p.sinD[pos * 8 + f - 32] = sn; }
    }
}

DI void stage_store(float* stg, const float (&v0)[16], const float (&v1)[16], u16* base, size_t ld, int lane, bool nt = true) {
    const int r = lane & 31, h = lane >> 5;
#pragma unroll
    for (int i = 0; i < 16; ++i) { stg[crow(i, h) * 68 + r] = v0[i]; stg[crow(i, h) * 68 + 32 + r] = v1[i]; }
    __builtin_amdgcn_wave_barrier();
#pragma unroll
    for (int j = 0; j < 4; ++j) {
        const int row = (lane >> 3) + 8 * j, ch = lane & 7;
        const f32x4 x = *(const f32x4*)(stg + row * 68 + ch * 8), y = *(const f32x4*)(stg + row * 68 + ch * 8 + 4);
        u32x4 w; w.x = pk2(x.x, x.y); w.y = pk2(x.z, x.w); w.z = pk2(y.x, y.y); w.w = pk2(y.z, y.w);
        if (nt) __builtin_nontemporal_store(w, (u32x4*)(base + (size_t)row * ld + ch * 8));
        else *(u32x4*)(base + (size_t)row * ld + ch * 8) = w;
    }
    __builtin_amdgcn_wave_barrier();
}
DI void store_tr(u16* tb, const float (&v0)[16], const float (&v1)[16], int r, int h, bool nt = true) {
#pragma unroll
    for (int G = 0; G < 2; ++G) {
        u32x4 w0, w1;
        w0.x = pk2(v0[8 * G + 0], v0[8 * G + 1]); w0.y = pk2(v0[8 * G + 2], v0[8 * G + 3]); w0.z = pk2(v0[8 * G + 4], v0[8 * G + 5]); w0.w = pk2(v0[8 * G + 6], v0[8 * G + 7]);
        w1.x = pk2(v1[8 * G + 0], v1[8 * G + 1]); w1.y = pk2(v1[8 * G + 2], v1[8 * G + 3]); w1.z = pk2(v1[8 * G + 4], v1[8 * G + 5]); w1.w = pk2(v1[8 * G + 6], v1[8 * G + 7]);
        if (nt) { __builtin_nontemporal_store(w0, (u32x4*)(tb + (size_t)r * 64 + 16 * G + 8 * h)); __builtin_nontemporal_store(w1, (u32x4*)(tb + (size_t)(32 + r) * 64 + 16 * G + 8 * h)); }
        else { *(u32x4*)(tb + (size_t)r * 64 + 16 * G + 8 * h) = w0; *(u32x4*)(tb + (size_t)(32 + r) * 64 + 16 * G + 8 * h) = w1; }
    }
}
template <int MI> DI void p1_epilogue(const Params& p, const f32x16 (&acc)[MI][2], int mt, int nt, int wm, int wn, int lane, float* stg) {
    const int r = lane & 31, h = lane >> 5;
    const int seg = nt >> 2;
    const int cseg0 = (nt & 3) * 128 + wn * 64;
#pragma unroll
    for (int mi = 0; mi < MI; ++mi) {
        const int tok0 = mt * (64 * MI) + wm * (32 * MI) + mi * 32;
        const bool samp = tok0 >= TP;
        int bseq, t0;
        if (!samp) { bseq = tok0 >> 13; t0 = tok0 & 8191; } else { const int st = tok0 - TP; bseq = st >> 6; t0 = st & 63; }
        const int pos0 = samp ? PAST + t0 : t0;
        float v0[16], v1[16];
        if (seg == 0 || seg == 1) {
            const int head = cseg0 >> 6;
            const float sc = seg == 0 ? 1.f : 0.125f;
            {
                const int pb = pos0 + 4 * h;
                float cg = p.cosR[pb * 32 + r], sg = p.sinR[pb * 32 + r];
                const float c1 = p.cosR[32 + r], s1 = p.sinR[32 + r], c8 = p.cosR[256 + r], s8 = p.sinR[256 + r];
#pragma unroll
                for (int g = 0; g < 4; ++g) {
                    float c = cg, s = sg;
#pragma unroll
                    for (int b = 0; b < 4; ++b) {
                        const int i = 4 * g + b;
                        const float a0 = acc[mi][0][i], a1 = acc[mi][1][i];
                        v0[i] = (a0 * c - a1 * s) * sc; v1[i] = (a1 * c + a0 * s) * sc;
                        const float cn = c * c1 - s * s1, sn = s * c1 + c * s1; c = cn; s = sn;
                    }
                    const float cn = cg * c8 - sg * s8, sn = sg * c8 + cg * s8; cg = cn; sg = sn;
                }
            }
            stage_store(stg, v0, v1, (seg == 0 ? p.RQ : p.RK) + (size_t)tok0 * 512 + cseg0, 512, lane);
            if (seg == 1) {
                const float lg = log2_gamma(head);
                u16* tb = (samp ? p.RKtd + TR_S_OFF + (size_t)(bseq * 8 + head) * 4096 : p.RKtd + ((size_t)(bseq * 8 + head) * 128 + (t0 >> 6)) * 4096) + (t0 & 63);
#pragma unroll
                for (int i = 0; i < 16; ++i) { const float dc = __builtin_amdgcn_exp2f(lg * (float)(63 - ((t0 + crow(i, h)) & 63))); v0[i] *= dc; v1[i] *= dc; }
                store_tr(tb, v0, v1, r, h);
            }
        } else if (seg == 2) {
            const int head = cseg0 >> 6;
            u16* tb = (samp ? p.RVt + TR_S_OFF + (size_t)(bseq * 8 + head) * 4096 : p.RVt + ((size_t)(bseq * 8 + head) * 128 + (t0 >> 6)) * 4096) + (t0 & 63);
#pragma unroll
            for (int i = 0; i < 16; ++i) { v0[i] = acc[mi][0][i]; v1[i] = acc[mi][1][i]; }
            store_tr(tb, v0, v1, r, h);
        } else if (seg == 3 || seg == 7) {
#pragma unroll
            for (int i = 0; i < 16; ++i) { v0[i] = silu(acc[mi][0][i]); v1[i] = silu(acc[mi][1][i]); }
            stage_store(stg, v0, v1, (seg == 3 ? p.RG : p.DG) + (size_t)tok0 * 512 + cseg0, 512, lane);
        } else if (seg == 4 || seg == 5) {
            {
                const int pb = pos0 + 4 * h, f = r & 7;
                float cg = p.cosD[pb * 8 + f], sg = p.sinD[pb * 8 + f];
                const float c1 = p.cosD[8 + f], s1 = p.sinD[8 + f], c8 = p.cosD[64 + f], s8 = p.sinD[64 + f];
#pragma unroll
                for (int g = 0; g < 4; ++g) {
                    float c = cg, s = sg;
#pragma unroll
                    for (int b = 0; b < 4; ++b) {
                        const int i = 4 * g + b;
                        const float v = acc[mi][0][i], pr = __int_as_float(__builtin_amdgcn_update_dpp(0, __float_as_int(v), 0x128, 0xf, 0xf, false));
                        v0[i] = r < 8 ? v * c - pr * s : (r < 16 ? v * c + pr * s : v); v1[i] = acc[mi][1][i];
                        const float cn = c * c1 - s * s1, sn = s * c1 + c * s1; c = cn; s = sn;
                    }
                    const float cn = cg * c8 - sg * s8, sn = sg * c8 + cg * s8; cg = cn; sg = sn;
                }
            }
            if (seg == 4) {
#pragma unroll
                for (int i = 0; i < 16; ++i) { v0[i] *= QSCALE; v1[i] *= QSCALE; }
                stage_store(stg, v0, v1, p.DQ + (size_t)tok0 * 512 + cseg0, 512, lane);
            } else {
                float* ko = (samp ? p.out + O_KS + (size_t)(tok0 - TP) * 512 : p.out + O_KP + (size_t)tok0 * 512) + cseg0 + r;
                const int head4 = cseg0 >> 7, colh = cseg0 & 127;
                u16* kb = (samp ? p.SK + ((size_t)(bseq * 4 + head4) * 17 + 16) * 8192 : p.DKp + ((size_t)(bseq * 4 + head4) * 128 + (t0 >> 6)) * 8192) + (t0 & 63) * 128 + colh;
#pragma unroll
                for (int i = 0; i < 16; ++i) { const size_t ro = (size_t)crow(i, h) * 512; __builtin_nontemporal_store(v0[i], ko + ro); __builtin_nontemporal_store(v1[i], ko + ro + 32); }
                stage_store(stg, v0, v1, kb, 128, lane, false);
            }
        } else {
            float* vo = (samp ? p.out + O_VS + (size_t)(tok0 - TP) * 512 : p.out + O_VP + (size_t)tok0 * 512) + cseg0 + r;
            const int head4 = cseg0 >> 7, dv0 = cseg0 & 127;
            u16* tb = (samp ? p.SVt + ((size_t)(bseq * 4 + head4) * 17 + 16) * 8192 : p.DVtp + ((size_t)(bseq * 4 + head4) * 128 + (t0 >> 6)) * 8192) + dv0 * 64 + (t0 & 63);
#pragma unroll
            for (int i = 0; i < 16; ++i) { v0[i] = acc[mi][0][i]; v1[i] = acc[mi][1][i]; const size_t ro = (size_t)crow(i, h) * 512; __builtin_nontemporal_store(v0[i], vo + ro); __builtin_nontemporal_store(v1[i], vo + ro + 32); }
            store_tr(tb, v0, v1, r, h, false);
        }
    }
}

template <int MI> DI void gemm_core(const u16* __restrict__ Ag, const u16* __restrict__ Bg, u16* smem16, f32x16 (&acc)[MI][2], int tid) {
    constexpr int AST = 64 * MI * 40, STAGE = AST + 128 * 40;
    const int lane = tid & 63, wid = tid >> 6, r = lane & 31, h = lane >> 5, wm = wid >> 1, wn = wid & 1, lrow = tid >> 2, lch = tid & 3;
    const u16* ag = Ag + (size_t)lrow * 1024 + lch * 8; const u16* bg = Bg + (size_t)lrow * 1024 + lch * 8;
    const int wofs = lrow * 40 + lch * 8;
    const int afo = (32 * MI * wm + r) * 40 + 8 * h, bfo = AST + (64 * wn + r) * 40 + 8 * h;
#pragma unroll
    for (int a = 0; a < MI; ++a) { acc[a][0] = zero16(); acc[a][1] = zero16(); }
    u32x4 ra[MI], rb[2];
#pragma unroll
    for (int i = 0; i < MI; ++i) ra[i] = *(const u32x4*)(ag + (size_t)i * 64 * 1024);
#pragma unroll
    for (int i = 0; i < 2; ++i) rb[i] = *(const u32x4*)(bg + (size_t)i * 64 * 1024);
    __syncthreads();
#pragma unroll
    for (int i = 0; i < MI; ++i) *(u32x4*)(smem16 + wofs + i * 64 * 40) = ra[i];
#pragma unroll
    for (int i = 0; i < 2; ++i) *(u32x4*)(smem16 + AST + wofs + i * 64 * 40) = rb[i];
#pragma unroll
    for (int i = 0; i < MI; ++i) ra[i] = *(const u32x4*)(ag + (size_t)i * 64 * 1024 + 32);
#pragma unroll
    for (int i = 0; i < 2; ++i) rb[i] = *(const u32x4*)(bg + (size_t)i * 64 * 1024 + 32);
    __syncthreads();
    for (int kt = 0; kt < 32; ++kt) {
        const u16* cur = smem16 + (kt & 1) * STAGE;
        u16* nxt = smem16 + ((kt & 1) ^ 1) * STAGE;
        bf16x8 a0[MI], b0[2], a1[MI], b1[2];
#pragma unroll
        for (int mi = 0; mi < MI; ++mi) a0[mi] = *(const bf16x8*)(cur + afo + mi * 32 * 40);
#pragma unroll
        for (int ni = 0; ni < 2; ++ni) b0[ni] = *(const bf16x8*)(cur + bfo + ni * 32 * 40);
        __builtin_amdgcn_sched_barrier(0);
        if (kt < 31) {
#pragma unroll
            for (int i = 0; i < MI; ++i) *(u32x4*)(nxt + wofs + i * 64 * 40) = ra[i];
#pragma unroll
            for (int i = 0; i < 2; ++i) *(u32x4*)(nxt + AST + wofs + i * 64 * 40) = rb[i];
            if (kt < 30) {
#pragma unroll
                for (int i = 0; i < MI; ++i) ra[i] = *(const u32x4*)(ag + (size_t)i * 64 * 1024 + (kt + 2) * 32);
#pragma unroll
                for (int i = 0; i < 2; ++i) rb[i] = *(const u32x4*)(bg + (size_t)i * 64 * 1024 + (kt + 2) * 32);
            }
        }
#pragma unroll
        for (int mi = 0; mi < MI; ++mi) a1[mi] = *(const bf16x8*)(cur + afo + mi * 32 * 40 + 16);
#pragma unroll
        for (int ni = 0; ni < 2; ++ni) b1[ni] = *(const bf16x8*)(cur + bfo + ni * 32 * 40 + 16);
        __builtin_amdgcn_sched_barrier(0);
#pragma unroll
        for (int mi = 0; mi < MI; ++mi) { acc[mi][0] = MFMA32(a0[mi], b0[0], acc[mi][0]); acc[mi][1] = MFMA32(a0[mi], b0[1], acc[mi][1]); }
#pragma unroll
        for (int mi = 0; mi < MI; ++mi) { acc[mi][0] = MFMA32(a1[mi], b1[0], acc[mi][0]); acc[mi][1] = MFMA32(a1[mi], b1[1], acc[mi][1]); }
        __syncthreads();
    }
}

__device__ void p1_gemm(const Params& p, unsigned char* smem) {
    for (int tile_ = blockIdx.x; tile_ < 136 * 32 * REP1; tile_ += gridDim.x) {
        int tid = threadIdx.x; asm volatile("" : "+v"(tid));
        const int tile = tile_ % (136 * 32);
        int mt = tile >> 5, nt = tile & 31;
        if (tile < 4096 && (gridDim.x & 511) == 0) {
            const int rnd = tile >> 9, b = tile & 511, x = b & 7, idx = b >> 3;
            mt = rnd * 16 + 4 * (x >> 1) + (idx >> 4); nt = 16 * (x & 1) + (idx & 15);
        }
        f32x16 acc[4][2];
        gemm_core<4>(p.H + (size_t)mt * 256 * 1024, p.WtIn + (size_t)nt * 128 * 1024, (u16*)smem, acc, tid);
        __syncthreads();
        p1_epilogue<4>(p, acc, mt, nt, (tid >> 6) >> 1, (tid >> 6) & 1, tid & 63, (float*)smem + (tid >> 6) * (32 * 68));
    }
    {
        int tid = threadIdx.x; asm volatile("" : "+v"(tid));
        int* s_item = (int*)(smem + 73728);
        float* tile0 = (float*)smem; float* tile1 = tile0 + 64 * 65;
        for (;;) {
            __syncthreads();
            if (tid == 0) *s_item = (int)atomicAdd(p.ctr + 8 * 32, 1u);
            __syncthreads();
            const int j = __builtin_amdgcn_readfirstlane(*s_item);
            if (j >= 4096) break;
            if (j < 2048) {
                const TJob j0 = tjob(p, 1280 + 2 * j), j1 = tjob(p, 1280 + 2 * j + 1);
                f32x4 v0[4], v1[4];
                tr_load(j0, v0, tid); tr_load(j1, v1, tid);
                tr_put(v0, tile0, tid); tr_put(v1, tile1, tid);
                __syncthreads();
                tr_store(j0, tile0, tid); tr_store(j1, tile1, tid);
            } else {
                const size_t base = (size_t)(j - 2048) * 2048;
                f32x4 v[8];
#pragma unroll
                for (int q = 0; q < 8; ++q) v[q] = __builtin_nontemporal_load((const f32x4*)(p.cache_k + (base + tid + 256 * q) * 4));
#pragma unroll
                for (int q = 0; q < 8; ++q) {
                    const size_t i = base + tid + 256 * q, row = i >> 7; const int c4 = (int)(i & 127), sb = (int)(row >> 10), t = (int)(row & 1023);
                    u32x2 w; w.x = pk2(v[q].x, v[q].y); w.y = pk2(v[q].z, v[q].w);
                    *(u32x2*)(p.SK + ((size_t)(sb * 4 + (c4 >> 5)) * 17 + (t >> 6)) * 8192 + (t & 63) * 128 + (c4 & 31) * 4) = w;
                }
            }
        }
    }
}

constexpr int KV_STAGE = 2 * 128 * 72;
__device__ void attn_unit(const Params& p, unsigned char* smem, const u16* __restrict__ qptr, const u16* __restrict__ kptr, const u16* __restrict__ vtptr,
                          int ntiles, int tok0, int head) {
    u16* sKV = (u16*)smem;
    int tid = threadIdx.x; asm volatile("" : "+v"(tid)); const int lane = tid & 63, wid = tid >> 6, r = lane & 31, h = lane >> 5, c = wid & 1, rg = wid >> 1;
    bf16x8 qf[4];
#pragma unroll
    for (int ks = 0; ks < 4; ++ks) qf[ks] = *(const bf16x8*)(qptr + (size_t)(32 * rg + r) * 512 + c * 64 + 16 * ks + 8 * h);
    f32x16 O[4];
#pragma unroll
    for (int i = 0; i < 4; ++i) O[i] = zero16();
    float m = -1e30f, l = 0.f;
    const int kkey = tid >> 4, kcc = tid & 15;
    const int vdv = tid >> 3, vch = tid & 7;
    const u16* kg = kptr + tid * 8;
    const u16* vg = vtptr + tid * 8;
    const int klo = ((kcc >> 3) * 64 + kkey) * 72 + (kcc & 7) * 8;
    const int vlo = 128 * 72 + vdv * 72 + vch * 8;
    const int kfo = (c * 64 + r) * 72 + 8 * h;
    const int vfo = 128 * 72 + r * 72 + 8 * h;
    u32x4 rk[4], rv[4];
#pragma unroll
    for (int i = 0; i < 4; ++i) { rk[i] = *(const u32x4*)(kg + i * 2048); rv[i] = *(const u32x4*)(vg + i * 2048); }
    __syncthreads();
#pragma unroll
    for (int i = 0; i < 4; ++i) { *(u32x4*)(sKV + klo + i * 16 * 72) = rk[i]; *(u32x4*)(sKV + vlo + i * 32 * 72) = rv[i]; }
    if (ntiles > 1) {
#pragma unroll
        for (int i = 0; i < 4; ++i) { rk[i] = *(const u32x4*)(kg + 8192 + i * 2048); rv[i] = *(const u32x4*)(vg + 8192 + i * 2048); }
    }
    __syncthreads();
    for (int kt = 0; kt < ntiles; ++kt) {
        const u16* cur = sKV + (kt & 1) * KV_STAGE;
        u16* nxt = sKV + ((kt & 1) ^ 1) * KV_STAGE;
        bf16x8 kf[2][4];
#pragma unroll
        for (int ks = 0; ks < 4; ++ks) { kf[0][ks] = *(const bf16x8*)(cur + kfo + 16 * ks); kf[1][ks] = *(const bf16x8*)(cur + kfo + 32 * 72 + 16 * ks); }
        __builtin_amdgcn_sched_barrier(0);
        f32x16 S0 = zero16(), S1 = zero16();
#pragma unroll
        for (int ks = 0; ks < 4; ++ks) { S0 = MFMA32(kf[0][ks], qf[ks], S0); S1 = MFMA32(kf[1][ks], qf[ks], S1); __builtin_amdgcn_sched_barrier(0); }
        bf16x8 va[4][2];
#pragma unroll
        for (int d = 0; d < 4; ++d)
#pragma unroll
            for (int q = 0; q < 2; ++q) va[d][q] = *(const bf16x8*)(cur + vfo + d * 32 * 72 + 16 * q);
        if (kt + 1 < ntiles) {
#pragma unroll
            for (int i = 0; i < 4; ++i) { *(u32x4*)(nxt + klo + i * 16 * 72) = rk[i]; *(u32x4*)(nxt + vlo + i * 32 * 72) = rv[i]; }
            if (kt + 2 < ntiles) {
#pragma unroll
                for (int i = 0; i < 4; ++i) { rk[i] = *(const u32x4*)(kg + (size_t)(kt + 2) * 8192 + i * 2048); rv[i] = *(const u32x4*)(vg + (size_t)(kt + 2) * 8192 + i * 2048); }
            }
        }
        __builtin_amdgcn_sched_barrier(0);
        float mt = fmaxf(S0[0], S1[0]);
#pragma unroll
        for (int i = 1; i < 16; ++i) mt = fmaxf(mt, fmaxf(S0[i], S1[i]));
        mt = xhalf_max(mt);
        if (__any(mt > m)) {
            const float mn = fmaxf(m, mt), al = __builtin_amdgcn_exp2f(m - mn);
            m = mn; l *= al;
#pragma unroll
            for (int d = 0; d < 4; ++d)
#pragma unroll
                for (int i = 0; i < 16; ++i) O[d][i] *= al;
        }
        const f32x2 m2 = {m, m};
        f32x2 l2 = {0.f, 0.f};
        u32x4 pw[4];
#pragma unroll
        for (int j = 0; j < 8; ++j) {
            f32x2 x0 = {S0[2 * j], S0[2 * j + 1]};
            x0 = x0 - m2;
            f32x2 e0; e0.x = __builtin_amdgcn_exp2f(x0.x); e0.y = __builtin_amdgcn_exp2f(x0.y);
            l2 = l2 + e0;
            pw[j >> 2][j & 3] = pk2(e0.x, e0.y);
        }
        const bf16x8 p00 = __builtin_bit_cast(bf16x8, pw[0]), p01 = __builtin_bit_cast(bf16x8, pw[1]);
        bf16x8 vb[4][2];
#pragma unroll
        for (int d = 0; d < 4; ++d)
#pragma unroll
            for (int q = 0; q < 2; ++q) vb[d][q] = *(const bf16x8*)(cur + vfo + d * 32 * 72 + 32 + 16 * q);
#pragma unroll
        for (int j = 0; j < 8; ++j) {
            O[j & 3] = MFMA32(va[j & 3][j >> 2], (j >> 2) ? p01 : p00, O[j & 3]);
            f32x2 x1 = {S1[2 * j], S1[2 * j + 1]};
            x1 = x1 - m2;
            f32x2 e1; e1.x = __builtin_amdgcn_exp2f(x1.x); e1.y = __builtin_amdgcn_exp2f(x1.y);
            l2 = l2 + e1;
            pw[2 + (j >> 2)][j & 3] = pk2(e1.x, e1.y);
        }
        l += l2.x + l2.y;
        const bf16x8 p10 = __builtin_bit_cast(bf16x8, pw[2]), p11 = __builtin_bit_cast(bf16x8, pw[3]);
#pragma unroll
        for (int j = 0; j < 8; ++j) O[j & 3] = MFMA32(vb[j & 3][j >> 2], (j >> 2) ? p11 : p10, O[j & 3]);
        __syncthreads();
    }
    const float inv = 1.f / xhalf_sum(l);
    const float lam = p.misc[0];
    float* ex = (float*)smem + rg * 4096;
    if (c == 1) {
        const float sc = inv * lam;
#pragma unroll
        for (int d = 0; d < 4; ++d)
#pragma unroll
            for (int i = 0; i < 16; ++i) ex[(d * 16 + i) * 64 + lane] = O[d][i] * sc;
    }
    __syncthreads();
    if (c == 0) {
        float ss = 0.f;
#pragma unroll
        for (int d = 0; d < 4; ++d)
#pragma unroll
            for (int i = 0; i < 16; ++i) { const float v = O[d][i] * inv - ex[(d * 16 + i) * 64 + lane]; O[d][i] = v; ss += v * v; }
        ss += __shfl_xor(ss, 32);
        const float rstd = rsqrtf(ss * (1.f / 128.f) + EPS) * 0.8f;
        const size_t tok = (size_t)(tok0 + 32 * rg + r);
#pragma unroll
        for (int d = 0; d < 4; ++d)
#pragma unroll
            for (int g = 0; g < 4; ++g) {
                const int dv0 = 32 * d + 8 * g + 4 * h;
                const u32x2 gt = *(const u32x2*)(p.DG + tok * 512 + head * 128 + dv0);
                const f32x4 gn = *(const f32x4*)(p.diff_norm_g + dv0);
                u32x2 w;
                w.x = pk2(O[d][4 * g + 0] * rstd * gn.x * bf2f(gt.x & 0xffffu), O[d][4 * g + 1] * rstd * gn.y * bf2f(gt.x >> 16));
                w.y = pk2(O[d][4 * g + 2] * rstd * gn.z * bf2f(gt.y & 0xffffu), O[d][4 * g + 3] * rstd * gn.w * bf2f(gt.y >> 16));
                *(u32x2*)(p.MIX + tok * 1024 + 512 + head * 128 + dv0) = w;
            }
    }
}

__device__ void ret_scan_item(const Params& p, int seqi, int hd) {
    int tid = threadIdx.x; asm volatile("" : "+v"(tid)); const int lane = tid & 63, wid = tid >> 6, r = lane & 31, h = lane >> 5, dvb = wid >> 1, dkb = wid & 1;
    const bool samp = seqi >= 4; const int sb = seqi - 4;
    const size_t tbase = samp ? TR_S_OFF + (size_t)(sb * 8 + hd) * 4096 : ((size_t)(seqi * 8 + hd) * 128) * 4096;
    const u16* vt = p.RVt + tbase + (size_t)(32 * dvb + r) * 64 + 8 * h;
    const u16* kt = p.RKtd + tbase + (size_t)(32 * dkb + r) * 64 + 8 * h;
    const int nch = samp ? 1 : 128;
    u16* sprev = p.SPREV + (size_t)(samp ? 4096 + sb * 8 + hd : (seqi * 8 + hd) * 128) * 4096;
    float* so = samp ? p.out + O_SS + (size_t)(sb * 8 + hd) * 4096 : p.out + O_SP + (size_t)(seqi * 8 + hd) * 4096;
    const int dk = 32 * dkb + r;
    f32x16 S = zero16();
    if (samp) {
        const float* si = p.state_ret + (size_t)(sb * 8 + hd) * 4096 + (size_t)dk * 64 + 32 * dvb + 4 * h;
#pragma unroll
        for (int g = 0; g < 4; ++g) { const f32x4 v = *(const f32x4*)(si + 8 * g); S[4 * g] = v.x; S[4 * g + 1] = v.y; S[4 * g + 2] = v.z; S[4 * g + 3] = v.w; }
    }
    const float g64 = exp2f(log2_gamma(hd) * 64.f);
    bf16x8 an[4], bn[4];
#pragma unroll
    for (int ks = 0; ks < 4; ++ks) { an[ks] = *(const bf16x8*)(vt + 16 * ks); bn[ks] = *(const bf16x8*)(kt + 16 * ks); }
    for (int c = 0; c < nch; ++c) {
        bf16x8 a[4], b[4];
#pragma unroll
        for (int ks = 0; ks < 4; ++ks) { a[ks] = an[ks]; b[ks] = bn[ks]; }
        if (c + 1 < nch) {
#pragma unroll
            for (int ks = 0; ks < 4; ++ks) { an[ks] = *(const bf16x8*)(vt + (size_t)(c + 1) * 4096 + 16 * ks); bn[ks] = *(const bf16x8*)(kt + (size_t)(c + 1) * 4096 + 16 * ks); }
        }
#pragma unroll
        for (int i = 0; i < 16; ++i) sprev[(size_t)c * 4096 + (32 * dvb + crow(i, h)) * 64 + dk] = f2bf(S[i]);
        f32x16 KV = zero16();
#pragma unroll
        for (int ks = 0; ks < 4; ++ks) KV = MFMA32(a[ks], b[ks], KV);
#pragma unroll
        for (int i = 0; i < 16; ++i) S[i] = g64 * S[i] + KV[i];
    }
#pragma unroll
    for (int g = 0; g < 4; ++g) { f32x4 v = {S[4 * g], S[4 * g + 1], S[4 * g + 2], S[4 * g + 3]}; *(f32x4*)(so + (size_t)dk * 64 + 32 * dvb + 4 * h + 8 * g) = v; }
    asm volatile("s_waitcnt vmcnt(0)" ::: "memory");
    __syncthreads();
    if (tid == 0) {
        __builtin_amdgcn_fence(__ATOMIC_RELEASE, "agent");
        asm volatile("s_waitcnt vmcnt(0)" ::: "memory");
        __hip_atomic_fetch_add(p.done + seqi * 2 + (hd >> 2), 1u, __ATOMIC_RELAXED, __HIP_MEMORY_SCOPE_AGENT);
    }
}

__device__ void p3_tile(const Params& p, int tile, int hh) {
    int tid = threadIdx.x;
    asm volatile("" : "+v"(tid));
    const int lane = tid & 63, wid = tid >> 6, r = lane & 31, h = lane >> 5;
    int hf, tokc, unit0, ustride; size_t vtb, L, pos0;
    if (tile < 1024) { const int b = tile >> 8, c = (tile >> 1) & 127; hf = tile & 1; tokc = b * 8192 + c * 64; unit0 = (b * 8) * 128 + c; ustride = 128; vtb = ((size_t)(b * 8) * 128 + c) * 4096; L = 128 * 4096; pos0 = 0; }
    else { const int k = tile - 1024, sb = k >> 1; hf = k & 1; tokc = TP + sb * 64; unit0 = 4096 + sb * 8; ustride = 1; vtb = TR_S_OFF + (size_t)(sb * 8) * 4096; L = 4096; pos0 = 0; }
    const int tok0 = tokc + 32 * hf;
    const int qi = 32 * hf + r;
    {
        const int hd = 4 * hh + wid;
        const float lg = log2_gamma(hd);
        bf16x8 qf[4];
#pragma unroll
        for (int ks = 0; ks < 4; ++ks) qf[ks] = *(const bf16x8*)(p.RQ + (size_t)(tok0 + r) * 512 + hd * 64 + 16 * ks + 8 * h);
        __builtin_amdgcn_sched_barrier(0);
        f32x16 S0 = zero16(), S1 = zero16();
#pragma unroll
        for (int ks = 0; ks < 4; ++ks) S0 = MFMA32(*(const bf16x8*)(p.RK + (size_t)(tokc + r) * 512 + hd * 64 + 16 * ks + 8 * h), qf[ks], S0);
        if (hf) {
#pragma unroll
            for (int ks = 0; ks < 4; ++ks) S1 = MFMA32(*(const bf16x8*)(p.RK + (size_t)(tokc + 32 + r) * 512 + hd * 64 + 16 * ks + 8 * h), qf[ks], S1);
        }
#pragma unroll
        for (int i = 0; i < 16; ++i) {
            const int k0 = crow(i, h), k1 = 32 + k0;
            S0[i] = qi >= k0 ? S0[i] * __builtin_amdgcn_exp2f(lg * (float)(qi - k0)) : 0.f;
            S1[i] = qi >= k1 ? S1[i] * __builtin_amdgcn_exp2f(lg * (float)(qi - k1)) : 0.f;
        }
        const bf16x8 p00 = pack8<0>(S0), p01 = pack8<1>(S0), p10 = pack8<0>(S1), p11 = pack8<1>(S1);
        __builtin_amdgcn_sched_barrier(0);
        const float qd = __builtin_amdgcn_exp2f(lg * (float)(qi + 1));
        const u16* vt = p.RVt + vtb + (size_t)hd * L + pos0 + 8 * h;
        const u16* sp = p.SPREV + (size_t)(unit0 + hd * ustride) * 4096 + 8 * h;
        float ss = 0.f;
        f32x16 o[2];
#pragma unroll
        for (int d = 0; d < 2; ++d) {
            f32x16 in = zero16(), cr = zero16();
            const u16* vr = vt + (size_t)(32 * d + r) * 64;
            in = MFMA32(*(const bf16x8*)(vr), p00, in);
            in = MFMA32(*(const bf16x8*)(vr + 16), p01, in);
            if (hf) { in = MFMA32(*(const bf16x8*)(vr + 32), p10, in); in = MFMA32(*(const bf16x8*)(vr + 48), p11, in); }
#pragma unroll
            for (int ks = 0; ks < 4; ++ks) cr = MFMA32(*(const bf16x8*)(sp + (32 * d + r) * 64 + 16 * ks), qf[ks], cr);
#pragma unroll
            for (int i = 0; i < 16; ++i) { const float v = in[i] + cr[i] * qd; o[d][i] = v; ss += v * v; }
            __builtin_amdgcn_sched_barrier(0);
        }
        ss += __shfl_xor(ss, 32);
        const float rstd = rsqrtf(ss * (1.f / 64.f) + EPS);
#pragma unroll
        for (int d = 0; d < 2; ++d)
#pragma unroll
            for (int g = 0; g < 4; ++g) {
                const int dv0 = 32 * d + 8 * g + 4 * h;
                const u32x2 gt = *(const u32x2*)(p.RG + (size_t)(tok0 + r) * 512 + hd * 64 + dv0);
                const f32x4 gn = *(const f32x4*)(p.ret_norm_g + hd * 64 + dv0);
                u32x2 w;
                w.x = pk2(o[d][4 * g + 0] * rstd * gn.x * bf2f(gt.x & 0xffffu), o[d][4 * g + 1] * rstd * gn.y * bf2f(gt.x >> 16));
                w.y = pk2(o[d][4 * g + 2] * rstd * gn.z * bf2f(gt.y & 0xffffu), o[d][4 * g + 3] * rstd * gn.w * bf2f(gt.y >> 16));
                *(u32x2*)(p.MIX + (size_t)(tok0 + r) * 1024 + hd * 64 + dv0) = w;
            }
    }
}


constexpr int XQ_ITEMS = 4 + 32 + 256 + 16 + 256 + 16;
DI void wait_done(const Params& p, int idx, int tid) {
    if (tid == 0) {
        unsigned sp = 0;
        while (__hip_atomic_load(p.done + idx, __ATOMIC_RELAXED, __HIP_MEMORY_SCOPE_AGENT) < 4u) { __builtin_amdgcn_s_sleep(2); if (++sp > (1u << 22)) break; }
        __builtin_amdgcn_fence(__ATOMIC_ACQUIRE, "agent");
        asm volatile("s_waitcnt vmcnt(0)" ::: "memory");
    }
    __syncthreads();
}
__device__ void p2_mix(const Params& p, unsigned char* smem) {
    int* s_item = (int*)(smem + 73728);
    int tid = threadIdx.x; asm volatile("" : "+v"(tid));
    const int xcc = (int)(xb_xcc_id() & 7u);
    for (int q = 0; q < 8; ++q) {
        const int x = (xcc + q) & 7;
        while (true) {
            __syncthreads();
            if (tid == 0) *s_item = (int)atomicAdd(p.ctr + x * 32, 1u);
            __syncthreads();
            const int it = __builtin_amdgcn_readfirstlane(*s_item);
            if (it >= XQ_ITEMS) break;
            int kind, arg;
            if (it < 4) { kind = 0; arg = it; }
            else if (it < 36) { kind = 4; arg = it - 4; }
            else if (it < 228) { kind = 1; arg = it - 36; }
            else if (it < 244) { kind = 2; arg = it - 228; }
            else if (it < 564) { const int g = (it - 244) / 10, e = (it - 244) % 10; if (e < 2) { kind = 1; arg = 192 + 2 * g + e; } else { kind = 3; arg = 8 * g + (e - 2); } }
            else { kind = 3; arg = 256 + (it - 564); }
            if (kind == 0) { const int s = 4 * x + arg; ret_scan_item(p, s >> 3, s & 7); }
            else if (kind == 4) { const int k = 32 * x + arg; ret_scan_item(p, 4 + (k >> 3), k & 7); }
            else if (kind == 1) {
                const int k = arg, j = 127 - (k >> 1), bh = 2 * x + (k & 1), b = bh >> 2, hh = bh & 3;
                const int tok0 = b * 8192 + j * 64;
                attn_unit(p, smem, p.DQ + (size_t)tok0 * 512 + hh * 128, p.DKp + (size_t)(bh * 128) * 8192, p.DVtp + (size_t)(bh * 128) * 8192, j + 1, tok0, hh);
            } else if (kind == 2) {
                const int k = 16 * x + arg, sb = k >> 2, hh = k & 3;
                const int tok0 = TP + sb * 64;
                attn_unit(p, smem, p.DQ + (size_t)tok0 * 512 + hh * 128, p.SK + (size_t)(k * 17) * 8192, p.SVt + (size_t)(k * 17) * 8192, 17, tok0, hh);
            } else if (arg < 256) {
                const int b = x >> 1, hh = x & 1;
                wait_done(p, b * 2 + hh, tid);
                p3_tile(p, b * 256 + arg, hh);
            } else {
                const int k = arg - 256, sb = 4 * x + (k >> 2), hf = (k >> 1) & 1, hh = k & 1;
                wait_done(p, (4 + sb) * 2 + hh, tid);
                p3_tile(p, 1024 + sb * 2 + hf, hh);
            }
        }
    }
}

template <int MI> DI void p5_tile(const Params& p, unsigned char* smem, int row0, int nt, int tid) {
    f32x16 acc[MI][2];
    gemm_core<MI>(p.MIX + (size_t)row0 * 1024, p.WtOut + (size_t)nt * 128 * 1024, (u16*)smem, acc, tid);
    const int lane = tid & 63, wid = tid >> 6, r = lane & 31, h = lane >> 5, wm = wid >> 1, wn = wid & 1;
    float* red = (float*)smem;
    __syncthreads();
#pragma unroll
    for (int mi = 0; mi < MI; ++mi) {
        const int rl = wm * 32 * MI + mi * 32, tok0 = row0 + rl;
        const float* xb = (tok0 < TP ? p.x_p + (size_t)tok0 * D : p.x_s + (size_t)(tok0 - TP) * D) + nt * 128 + wn * 64 + r;
        float* yb = p.out + O_Y + (size_t)tok0 * D + nt * 128 + wn * 64 + r;
#pragma unroll
        for (int i = 0; i < 16; ++i) {
            const size_t ro = (size_t)crow(i, h) * D;
            const float v0 = acc[mi][0][i] + __builtin_nontemporal_load(xb + ro), v1 = acc[mi][1][i] + __builtin_nontemporal_load(xb + ro + 32);
            yb[ro] = v0; yb[ro + 32] = v1;
            float s = v0 * v0 + v1 * v1;
            s += __int_as_float(__builtin_amdgcn_update_dpp(0, __float_as_int(s), 0x121, 0xf, 0xf, false));
            s += __int_as_float(__builtin_amdgcn_update_dpp(0, __float_as_int(s), 0x122, 0xf, 0xf, false));
            s += __int_as_float(__builtin_amdgcn_update_dpp(0, __float_as_int(s), 0x124, 0xf, 0xf, false));
            s += __int_as_float(__builtin_amdgcn_update_dpp(0, __float_as_int(s), 0x128, 0xf, 0xf, false));
            s += __shfl_xor(s, 16);
            if (r == 0) red[wn * 64 * MI + rl + crow(i, h)] = s;
        }
    }
    __syncthreads();
    if (tid < 64 * MI) unsafeAtomicAdd(p.rowss + row0 + tid, red[tid] + red[64 * MI + tid]);
}
__device__ void p5_gemm(const Params& p, unsigned char* smem) {
    for (int tile_ = blockIdx.x; tile_ < (1024 + 256) * REP5; tile_ += gridDim.x) {
        int tid = threadIdx.x; asm volatile("" : "+v"(tid));
        const int tile = tile_ % (1024 + 256);
        if (tile < 1024) p5_tile<4>(p, smem, (tile >> 3) * 256, tile & 7, tid);
        else { const int t = tile - 1024; p5_tile<1>(p, smem, TP + (t >> 3) * 64, t & 7, tid); }
    }
}

__device__ void p6_norm(const Params& p) {
    const int tid = threadIdx.x, lane = tid & 63, wid = tid >> 6;
    f32x4 g[4];
#pragma unroll
    for (int i = 0; i < 4; ++i) g[i] = *(const f32x4*)(p.final_g + (lane + 64 * i) * 4);
    for (int row = (blockIdx.x * 4 + wid) * 2; row < T; row += gridDim.x * 8) {
        f32x4 v[2][4];
#pragma unroll
        for (int q = 0; q < 2; ++q)
#pragma unroll
            for (int i = 0; i < 4; ++i) v[q][i] = __builtin_nontemporal_load((const f32x4*)(p.out + O_Y + (size_t)(row + q) * D + (lane + 64 * i) * 4));
#pragma unroll
        for (int q = 0; q < 2; ++q) {
            const float rs = rsqrtf(p.rowss[row + q] * (1.f / 1024.f) + EPS);
#pragma unroll
            for (int i = 0; i < 4; ++i) { f32x4 o = v[q][i] * g[i] * rs; __builtin_nontemporal_store(o, (f32x4*)(p.out + O_Y + (size_t)(row + q) * D + (lane + 64 * i) * 4)); }
        }
    }
}

#define SMEM_DECL __shared__ __attribute__((aligned(16))) unsigned char smem[LDS_BYTES]
#if MULTI_LAUNCH
__global__ void __launch_bounds__(NTHREADS, 2) k_p0(Params p) { SMEM_DECL; p0_prep(p, smem); }
__global__ void __launch_bounds__(NTHREADS, 2) k_p1(Params p) { SMEM_DECL; p1_gemm(p, smem); }
__global__ void __launch_bounds__(NTHREADS, 2) k_p2(Params p) { SMEM_DECL; p2_mix(p, smem); }
__global__ void __launch_bounds__(NTHREADS, 2) k_p5(Params p) { SMEM_DECL; p5_gemm(p, smem); }
__global__ void __launch_bounds__(NTHREADS, 2) k_p6(Params p) { p6_norm(p); }
#else
__global__ void __launch_bounds__(NTHREADS, 2) fwd_megakernel(Params p) {
    SMEM_DECL;
    __shared__ uint4 xb_words;
    cg::grid_group grid = cg::this_grid();
    if (p.never) grid.sync();
    if (threadIdx.x == 0) xb_words = make_uint4(0u, 0u, 0u, 0u);
    __syncthreads();
    const XcdBarrier xb = xcd_barrier_post(p.bar, (volatile LAS unsigned*)&xb_words);
#pragma nounroll
    for (int rep = 0; rep < REP0; ++rep) p0_prep(p, smem);
    xcd_barrier(xb);
    p1_gemm(p, smem);
    xcd_barrier(xb);
    p2_mix(p, smem);
    xcd_barrier(xb);
    p5_gemm(p, smem);
    xcd_barrier(xb);
    p6_norm(p);
}
#endif

extern "C" void kernel_launch(void* const* d_in, const int* in_sizes, int n_in, void* d_out, int out_size, void* d_ws, size_t ws_size, hipStream_t stream) {
    Params p{};
    p.x_p = (const float*)d_in[0]; p.x_s = (const float*)d_in[1]; p.cache_k = (const float*)d_in[2]; p.cache_v = (const float*)d_in[3]; p.state_ret = (const float*)d_in[4];
    p.norm_g = (const float*)d_in[5]; p.w_in = (const float*)d_in[6]; p.w_out = (const float*)d_in[7]; p.ret_norm_g = (const float*)d_in[8]; p.diff_norm_g = (const float*)d_in[9];
    p.lam_q1 = (const float*)d_in[10]; p.lam_k1 = (const float*)d_in[11]; p.lam_q2 = (const float*)d_in[12]; p.lam_k2 = (const float*)d_in[13]; p.final_g = (const float*)d_in[14];
    p.out = (float*)d_out;
    unsigned char* w = (unsigned char*)d_ws; size_t off = 0;
    auto take = [&](size_t bytes) { unsigned char* r = w + off; off += (bytes + 255) & ~(size_t)255; return r; };
    const size_t HALF = (size_t)T * 512 * 2;
    p.H = (u16*)take(2 * HALF);
    p.MIX = p.H; p.SPREV = (u16*)take(HALF);
    p.WtIn = (u16*)take((size_t)4096 * 1024 * 2); p.WtOut = (u16*)take((size_t)1024 * 1024 * 2);
    p.RQ = (u16*)take(HALF); p.RK = (u16*)take(HALF); p.RKtd = (u16*)take(HALF); p.RVt = (u16*)take(HALF); p.RG = (u16*)take(HALF); p.DQ = (u16*)take(HALF); p.DG = (u16*)take(HALF);
    p.cosR = (float*)take(8192 * 32 * 4); p.sinR = (float*)take(8192 * 32 * 4); p.cosD = (float*)take(8192 * 8 * 4); p.sinD = (float*)take(8192 * 8 * 4);
    p.misc = (float*)take(256); p.ctr = (unsigned*)take(2048); p.done = (unsigned*)take(512); p.rowss = (float*)take((size_t)T * 4); p.bar = (unsigned*)take(XCD_BAR_WORDS * 4);
    unsigned char* yo = (unsigned char*)d_out; size_t yoff = 0;
    auto takey = [&](size_t bytes) { unsigned char* r = yo + yoff; yoff += (bytes + 255) & ~(size_t)255; return r; };
    p.DKp = (u16*)takey((size_t)TP * 512 * 2); p.SK = (u16*)takey((size_t)32 * SKL * 512 * 2); p.DVtp = (u16*)takey((size_t)2048 * 8192 * 2); p.SVt = (u16*)takey((size_t)16384 * SKL * 2);
    if (off > ws_size || yoff > (size_t)35651584 * 4) { fprintf(stderr, "workspace too small: need %zu have %zu\n", off, ws_size); return; }
#if MULTI_LAUNCH
    static int gb = 0;
    if (!gb) { int dev = 0, cus = 0; hipGetDevice(&dev); hipDeviceGetAttribute(&cus, hipDeviceAttributeMultiprocessorCount, dev); gb = cus * 2; }
    k_p0<<<gb, NTHREADS, 0, stream>>>(p); k_p1<<<gb, NTHREADS, 0, stream>>>(p); k_p2<<<gb, NTHREADS, 0, stream>>>(p); k_p5<<<gb, NTHREADS, 0, stream>>>(p); k_p6<<<gb, NTHREADS, 0, stream>>>(p);
#else
    static int grid_blocks = 0;
    if (!grid_blocks) {
        int dev = 0, cus = 0, per_cu = 0;
        hipGetDevice(&dev); hipDeviceGetAttribute(&cus, hipDeviceAttributeMultiprocessorCount, dev);
        hipOccupancyMaxActiveBlocksPerMultiprocessor(&per_cu, fwd_megakernel, NTHREADS, 0);
        if (per_cu > 2) per_cu = 2;
        if (per_cu < 1) per_cu = 1;
        grid_blocks = cus * per_cu;
    }
    hipMemsetAsync(p.bar, 0, XCD_BAR_WORDS * 4, stream);
    void* args[] = {&p};
    hipError_t e = hipLaunchCooperativeKernel((void*)fwd_megakernel, dim3(grid_blocks), dim3(NTHREADS), args, 0, stream);
    if (e != hipSuccess) fprintf(stderr, "cooperative launch failed: %s (grid %d)\n", hipGetErrorString(e), grid_blocks);
#endif
}
```

```cpp
#include <hip/hip_runtime.h>
#include <hip/hip_cooperative_groups.h>
#include <cstdio>
#include <cstdint>
namespace cg = cooperative_groups;

#ifndef REP1
#define REP1 1
#endif
#ifndef REP3
#define REP3 1
#endif
#ifndef REP5
#define REP5 1
#endif
#ifndef REP0
#define REP0 1
#endif
#ifndef MULTI_LAUNCH
#define MULTI_LAUNCH 0
#endif

typedef unsigned short u16;
typedef short bf16x8 __attribute__((ext_vector_type(8)));
typedef float f32x4 __attribute__((ext_vector_type(4)));
typedef float f32x2 __attribute__((ext_vector_type(2)));
typedef float f32x16 __attribute__((ext_vector_type(16)));
typedef unsigned u32x4 __attribute__((ext_vector_type(4)));
typedef unsigned u32x2 __attribute__((ext_vector_type(2)));
typedef __bf16 bf16x2_t __attribute__((ext_vector_type(2)));

#define DI __device__ __forceinline__
#define MFMA32(a, b, c) __builtin_amdgcn_mfma_f32_32x32x16_bf16((a), (b), (c), 0, 0, 0)

constexpr int D = 1024, TP = 32768, TS = 2048, T = TP + TS, PAST = 1024, SKL = 1088;
constexpr int NTHREADS = 256;
constexpr int LDS_BYTES = 73728 + 64;
constexpr float EPS = 1e-6f;
constexpr float QSCALE = 0.125f * 1.4426950408889634f;
constexpr size_t O_Y = 0, O_SP = 35651584, O_SS = 35782656, O_KP = 36831232, O_VP = 53608448, O_KS = 70385664, O_VS = 71434240;
constexpr size_t TR_S_OFF = 16777216;
constexpr int NITEMS = 32 + 2048 + 128 + 256;

struct Params {
    const float *x_p, *x_s, *cache_k, *cache_v, *state_ret, *norm_g, *w_in, *w_out, *ret_norm_g, *diff_norm_g, *lam_q1, *lam_k1, *lam_q2, *lam_k2, *final_g;
    float* out;
    u16 *H, *WtIn, *WtOut, *RQ, *RK, *RKtd, *RVt, *RG, *DQ, *DKp, *SK, *DVtp, *SVt, *DG, *MIX, *SPREV;
    float *cosR, *sinR, *cosD, *sinD, *misc, *rowss;
    unsigned* ctr; unsigned* bar; unsigned* done;
    int never; int pad_;
};

DI unsigned pk2(float lo, float hi) { f32x2 v = {lo, hi}; bf16x2_t b = __builtin_convertvector(v, bf16x2_t); return __builtin_bit_cast(unsigned, b); }
DI u16 f2bf(float x) { return (u16)(pk2(x, 0.f) & 0xffffu); }
DI float bf2f(unsigned v) { return __uint_as_float(v << 16); }
DI int crow(int i, int h) { return (i & 3) + 8 * (i >> 2) + 4 * h; }
DI float silu(float v) { return v / (1.f + __expf(-v)); }
DI float log2_gamma(int hd) {
    const float x = exp2f(-5.f - (float)hd);
    float s = x * (1.f + x * (0.5f + x * (1.f / 3.f + x * (0.25f + x * (0.2f + x * (1.f / 6.f))))));
    return -s * 1.4426950408889634f;
}
template <int S> DI bf16x8 pack8(const f32x16& x) {
    u32x4 p;
    p.x = pk2(x[8 * S + 0], x[8 * S + 1]); p.y = pk2(x[8 * S + 2], x[8 * S + 3]);
    p.z = pk2(x[8 * S + 4], x[8 * S + 5]); p.w = pk2(x[8 * S + 6], x[8 * S + 7]);
    return __builtin_bit_cast(bf16x8, p);
}
DI float xhalf_max(float v) { auto r = __builtin_amdgcn_permlane32_swap(__float_as_uint(v), __float_as_uint(v), false, false); return fmaxf(__uint_as_float(r[0]), __uint_as_float(r[1])); }
DI float xhalf_sum(float v) { auto r = __builtin_amdgcn_permlane32_swap(__float_as_uint(v), __float_as_uint(v), false, false); return __uint_as_float(r[0]) + __uint_as_float(r[1]); }
DI f32x16 zero16() { f32x16 z; for (int i = 0; i < 16; ++i) z[i] = 0.f; return z; }


#define XB_TMO      128
#define XB_XCNT(j)  (256  + 64 * (j))
#define XB_XSUB(j)  (1280 + 64 * (j))
#define XB_XGEN(j)  (2304 + 64 * (j))
#define XB_TOP      3328
#define XB_TOPGEN   3392
#define XCD_BAR_WORDS 3456
#define XB_SPIN_CAP (1u << 20)
#define LAS __attribute__((address_space(3)))
DI unsigned xb_ld(unsigned* p)              { return __hip_atomic_load(p, __ATOMIC_RELAXED, __HIP_MEMORY_SCOPE_AGENT); }
DI unsigned xb_add(unsigned* p, unsigned v) { return __hip_atomic_fetch_add(p, v, __ATOMIC_RELAXED, __HIP_MEMORY_SCOPE_AGENT); }
DI unsigned xb_xcc_id() { return (unsigned)__builtin_amdgcn_s_getreg((3 << 11) | 20) & 0xFu; }
#define XB_SPIN(cond, bar) do { unsigned _sp = 0; while (cond) { __builtin_amdgcn_s_sleep(1); \
    if ((++_sp & 255u) == 0u) { if (xb_ld(&(bar)[XB_TMO])) break; if (_sp > XB_SPIN_CAP) { atomicAdd(&(bar)[XB_TMO], 1u); break; } } } } while (0)
struct XcdBarrier { unsigned* bar; unsigned x; volatile LAS unsigned* st; };
DI XcdBarrier xcd_barrier_post(unsigned* bar, volatile LAS unsigned* st) {
    XcdBarrier b; b.bar = bar; b.x = xb_xcc_id(); b.st = st;
    if (threadIdx.x == 0) (void)xb_add(&bar[XB_XCNT(b.x)], 1u);
    return b;
}
DI void xcd_barrier_complete(unsigned* bar, unsigned x, unsigned& nloc, unsigned& nx) {
    const unsigned G = gridDim.x * gridDim.y * gridDim.z;
    unsigned sum, cnt, mine, sp = 0u;
    for (;;) {
        sum = 0u; cnt = 0u; mine = 0u;
#pragma unroll
        for (unsigned j = 0; j < 16; ++j) { const unsigned c = xb_ld(&bar[XB_XCNT(j)]); sum += c; cnt += (c > 0u) ? 1u : 0u; mine = (j == x) ? c : mine; }
        if (sum == G) break;
        __builtin_amdgcn_s_sleep(1);
        if ((++sp & 255u) == 0u) { if (xb_ld(&bar[XB_TMO])) break; if (sp > XB_SPIN_CAP) { atomicAdd(&bar[XB_TMO], 1u); break; } }
    }
    nloc = mine > 0u ? mine : 1u; nx = cnt > 0u ? cnt : 1u;
}
DI void xcd_barrier(const XcdBarrier& b) {
    asm volatile("s_waitcnt vmcnt(0)" ::: "memory");
    __syncthreads();
    if (threadIdx.x == 0) {
        unsigned* bar = b.bar;
        __builtin_amdgcn_s_waitcnt(0);
        unsigned nloc = b.st[0], nx = b.st[1];
        if (nloc == 0u) { xcd_barrier_complete(bar, b.x, nloc, nx); b.st[0] = nloc; b.st[1] = nx; }
        const unsigned old = xb_add(&bar[XB_XSUB(b.x)], 1u);
        const unsigned gen = old / nloc;
        if (old + 1u == (gen + 1u) * nloc) {
            __builtin_amdgcn_fence(__ATOMIC_RELEASE, "agent");
            asm volatile("s_waitcnt vmcnt(0)" ::: "memory");
            const unsigned og = xb_add(&bar[XB_TOP], 1u);
            const unsigned tg = og / nx;
            if (og + 1u == (tg + 1u) * nx) xb_add(&bar[XB_TOPGEN], 1u);
            else XB_SPIN(xb_ld(&bar[XB_TOPGEN]) == tg, bar);
            __builtin_amdgcn_fence(__ATOMIC_ACQUIRE, "agent");
            xb_add(&bar[XB_XGEN(b.x)], 1u);
            asm volatile("s_waitcnt vmcnt(0)" ::: "memory");
        } else {
            XB_SPIN(xb_ld(&bar[XB_XGEN(b.x)]) == gen, bar);
            __builtin_amdgcn_fence(__ATOMIC_ACQUIRE, "agent");
            asm volatile("s_waitcnt vmcnt(0)" ::: "memory");
        }
    }
    __syncthreads();
}

struct TJob { const float* src; size_t ss; u16* dst; size_t ds; bool perm; };
DI TJob tjob(const Params& p, int t) {
    TJob j;
    if (t < 1024) { const int kt = t >> 6, nt = t & 63;
        j.src = p.w_in + (size_t)kt * 64 * 4096 + nt * 64; j.ss = 4096; j.dst = p.WtIn + (size_t)nt * 64 * 1024 + kt * 64; j.ds = 1024; j.perm = false;
    } else if (t < 1280) { const int q = t - 1024, kt = q >> 4, nt = q & 15;
        j.src = p.w_out + (size_t)kt * 64 * 1024 + nt * 64; j.ss = 1024; j.dst = p.WtOut + (size_t)nt * 64 * 1024 + kt * 64; j.ds = 1024; j.perm = false;
    } else { const int q = t - 1280, sbh = q >> 5, keyt = (q >> 1) & 15, dvt = q & 1, sb = sbh >> 2, hh = sbh & 3;
        j.src = p.cache_v + ((size_t)sb * 1024 + keyt * 64) * 512 + hh * 128 + dvt * 64; j.ss = 512; j.dst = p.SVt + ((size_t)sbh * 17 + keyt) * 8192 + dvt * 64 * 64; j.ds = 64; j.perm = true;
    }
    return j;
}
DI void tr_load(const TJob& j, f32x4 (&v)[4], int tid) {
#pragma unroll
    for (int i = 0; i < 4; ++i) v[i] = __builtin_nontemporal_load((const f32x4*)(j.src + (size_t)((tid >> 4) + 16 * i) * j.ss + (tid & 15) * 4));
}
DI void tr_put(const f32x4 (&v)[4], float* tile, int tid) {
#pragma unroll
    for (int i = 0; i < 4; ++i) { const int r = (tid >> 4) + 16 * i, c4 = (tid & 15) * 4;
        tile[(c4 + 0) * 65 + r] = v[i].x; tile[(c4 + 1) * 65 + r] = v[i].y; tile[(c4 + 2) * 65 + r] = v[i].z; tile[(c4 + 3) * 65 + r] = v[i].w; }
}
DI void tr_store(const TJob& j, const float* tile, int tid) {
#pragma unroll
    for (int i = 0; i < 2; ++i) {
        const int id = tid + 256 * i, c = id >> 3, p0 = (id & 7) * 8;
        float e[8];
#pragma unroll
        for (int jj = 0; jj < 8; ++jj) { const int pos = p0 + jj; const int r = j.perm ? ((pos & ~12) | ((pos & 4) << 1) | ((pos & 8) >> 1)) : pos; e[jj] = tile[c * 65 + r]; }
        u32x4 w; w.x = pk2(e[0], e[1]); w.y = pk2(e[2], e[3]); w.z = pk2(e[4], e[5]); w.w = pk2(e[6], e[7]);
        *(u32x4*)(j.dst + (size_t)c * j.ds + p0) = w;
    }
}

__device__ void p0_prep(const Params& p, unsigned char* smem) {
    int tid = threadIdx.x; asm volatile("" : "+v"(tid)); const int lane = tid & 63, wid = tid >> 6, nb = gridDim.x, bid = blockIdx.x;
    if (bid == 0 && tid == 0) {
        float s1 = 0.f, s2 = 0.f;
        for (int i = 0; i < 64; ++i) { s1 += p.lam_q1[i] * p.lam_k1[i]; s2 += p.lam_q2[i] * p.lam_k2[i]; }
        p.misc[0] = expf(s1) - expf(s2) + 0.2f;
        for (int i = 0; i < 288; ++i) p.ctr[i] = 0u;
        for (int i = 0; i < 128; ++i) p.done[i] = 0u;
    }
    for (int i = bid * 256 + tid; i < T; i += nb * 256) p.rowss[i] = 0.f;
    for (int row = (bid * 4 + wid) * 2; row < T; row += nb * 8) {
        f32x4 v[2][4]; float ss[2] = {0.f, 0.f};
#pragma unroll
        for (int q = 0; q < 2; ++q) { const int rw = row + q; const float* src = rw < TP ? p.x_p + (size_t)rw * D : p.x_s + (size_t)(rw - TP) * D;
#pragma unroll
            for (int i = 0; i < 4; ++i) v[q][i] = __builtin_nontemporal_load((const f32x4*)(src + (lane + 64 * i) * 4)); }
        f32x4 g[4];
#pragma unroll
        for (int i = 0; i < 4; ++i) g[i] = *(const f32x4*)(p.norm_g + (lane + 64 * i) * 4);
#pragma unroll
        for (int q = 0; q < 2; ++q) {
#pragma unroll
            for (int i = 0; i < 4; ++i) ss[q] += v[q][i].x * v[q][i].x + v[q][i].y * v[q][i].y + v[q][i].z * v[q][i].z + v[q][i].w * v[q][i].w;
#pragma unroll
            for (int o = 32; o >= 1; o >>= 1) ss[q] += __shfl_xor(ss[q], o);
            const float rstd = rsqrtf(ss[q] * (1.f / 1024.f) + EPS);
#pragma unroll
            for (int i = 0; i < 4; ++i) {
                u32x2 w; w.x = pk2(v[q][i].x * rstd * g[i].x, v[q][i].y * rstd * g[i].y); w.y = pk2(v[q][i].z * rstd * g[i].z, v[q][i].w * rstd * g[i].w);
                *(u32x2*)(p.H + (size_t)(row + q) * D + (lane + 64 * i) * 4) = w;
            }
        }
    }
    float* tile0 = (float*)smem; float* tile1 = tile0 + 64 * 65;
    for (int t = bid; t < 1280; t += 2 * nb) {
        const bool two = t + nb < 1280;
        const TJob j0 = tjob(p, t), j1 = tjob(p, two ? t + nb : t);
        f32x4 v0[4], v1[4];
        tr_load(j0, v0, tid); if (two) tr_load(j1, v1, tid);
        __syncthreads();
        tr_put(v0, tile0, tid); if (two) tr_put(v1, tile1, tid);
        __syncthreads();
        tr_store(j0, tile0, tid); if (two) tr_store(j1, tile1, tid);
    }
    for (int i = bid * 256 + tid; i < 8192 * 40; i += nb * 256) {
        const int pos = i / 40, f = i % 40;
        const float inv = f < 32 ? exp2f(-13.287712379549449f * (float)f * (1.f / 32.f)) : exp2f(-18.931568569324174f * (float)(f - 32) * (1.f / 8.f));
        const float ang = (float)pos * inv;
        const double rev = (double)ang * 0.15915494309189535; const float fr = (float)(rev - rint(rev));
        const float sn = __builtin_amdgcn_sinf(fr), cs = __builtin_amdgcn_cosf(fr);
        if (f < 32) { p.cosR[pos * 32 + f] = cs; p.sinR[pos * 32 + f] = sn; } else { p.cosD[pos * 8 + f - 32] = cs; p.sinD[pos * 8 + f - 32] = sn; }
    }
}

DI void stage_store(float* stg, const float (&v0)[16], const float (&v1)[16], u16* base, size_t ld, int lane, bool nt = true) {
    const int r = lane & 31, h = lane >> 5;
#pragma unroll
    for (int i = 0; i < 16; ++i) { stg[crow(i, h) * 68 + r] = v0[i]; stg[crow(i, h) * 68 + 32 + r] = v1[i]; }
    __builtin_amdgcn_wave_barrier();
#pragma unroll
    for (int j = 0; j < 4; ++j) {
        const int row = (lane >> 3) + 8 * j, ch = lane & 7;
        const f32x4 x = *(const f32x4*)(stg + row * 68 + ch * 8), y = *(const f32x4*)(stg + row * 68 + ch * 8 + 4);
        u32x4 w; w.x = pk2(x.x, x.y); w.y = pk2(x.z, x.w); w.z = pk2(y.x, y.y); w.w = pk2(y.z, y.w);
        if (nt) __builtin_nontemporal_store(w, (u32x4*)(base + (size_t)row * ld + ch * 8));
        else *(u32x4*)(base + (size_t)row * ld + ch * 8) = w;
    }
    __builtin_amdgcn_wave_barrier();
}
DI void store_tr(u16* tb, const float (&v0)[16], const float (&v1)[16], int r, int h, bool nt = true) {
#pragma unroll
    for (int G = 0; G < 2; ++G) {
        u32x4 w0, w1;
        w0.x = pk2(v0[8 * G + 0], v0[8 * G + 1]); w0.y = pk2(v0[8 * G + 2], v0[8 * G + 3]); w0.z = pk2(v0[8 * G + 4], v0[8 * G + 5]); w0.w = pk2(v0[8 * G + 6], v0[8 * G + 7]);
        w1.x = pk2(v1[8 * G + 0], v1[8 * G + 1]); w1.y = pk2(v1[8 * G + 2], v1[8 * G + 3]); w1.z = pk2(v1[8 * G + 4], v1[8 * G + 5]); w1.w = pk2(v1[8 * G + 6], v1[8 * G + 7]);
        if (nt) { __builtin_nontemporal_store(w0, (u32x4*)(tb + (size_t)r * 64 + 16 * G + 8 * h)); __builtin_nontemporal_store(w1, (u32x4*)(tb + (size_t)(32 + r) * 64 + 16 * G + 8 * h)); }
        else { *(u32x4*)(tb + (size_t)r * 64 + 16 * G + 8 * h) = w0; *(u32x4*)(tb + (size_t)(32 + r) * 64 + 16 * G + 8 * h) = w1; }
    }
}
template <int MI> DI void p1_epilogue(const Params& p, const f32x16 (&acc)[MI][2], int mt, int nt, int wm, int wn, int lane, float* stg) {
    const int r = lane & 31, h = lane >> 5;
    const int seg = nt >> 2;
    const int cseg0 = (nt & 3) * 128 + wn * 64;
#pragma unroll
    for (int mi = 0; mi < MI; ++mi) {
        const int tok0 = mt * (64 * MI) + wm * (32 * MI) + mi * 32;
        const bool samp = tok0 >= TP;
        int bseq, t0;
        if (!samp) { bseq = tok0 >> 13; t0 = tok0 & 8191; } else { const int st = tok0 - TP; bseq = st >> 6; t0 = st & 63; }
        const int pos0 = samp ? PAST + t0 : t0;
        float v0[16], v1[16];
        if (seg == 0 || seg == 1) {
            const int head = cseg0 >> 6;
            const float sc = seg == 0 ? 1.f : 0.125f;
            {
                const int pb = pos0 + 4 * h;
                float cg = p.cosR[pb * 32 + r], sg = p.sinR[pb * 32 + r];
                const float c1 = p.cosR[32 + r], s1 = p.sinR[32 + r], c8 = p.cosR[256 + r], s8 = p.sinR[256 + r];
#pragma unroll
                for (int g = 0; g < 4; ++g) {
                    float c = cg, s = sg;
#pragma unroll
                    for (int b = 0; b < 4; ++b) {
                        const int i = 4 * g + b;
                        const float a0 = acc[mi][0][i], a1 = acc[mi][1][i];
                        v0[i] = (a0 * c - a1 * s) * sc; v1[i] = (a1 * c + a0 * s) * sc;
                        const float cn = c * c1 - s * s1, sn = s * c1 + c * s1; c = cn; s = sn;
                    }
                    const float cn = cg * c8 - sg * s8, sn = sg * c8 + cg * s8; cg = cn; sg = sn;
                }
            }
            stage_store(stg, v0, v1, (seg == 0 ? p.RQ : p.RK) + (size_t)tok0 * 512 + cseg0, 512, lane);
            if (seg == 1) {
                const float lg = log2_gamma(head);
                u16* tb = (samp ? p.RKtd + TR_S_OFF + (size_t)(bseq * 8 + head) * 4096 : p.RKtd + ((size_t)(bseq * 8 + head) * 128 + (t0 >> 6)) * 4096) + (t0 & 63);
#pragma unroll
                for (int i = 0; i < 16; ++i) { const float dc = __builtin_amdgcn_exp2f(lg * (float)(63 - ((t0 + crow(i, h)) & 63))); v0[i] *= dc; v1[i] *= dc; }
                store_tr(tb, v0, v1, r, h);
            }
        } else if (seg == 2) {
            const int head = cseg0 >> 6;
            u16* tb = (samp ? p.RVt + TR_S_OFF + (size_t)(bseq * 8 + head) * 4096 : p.RVt + ((size_t)(bseq * 8 + head) * 128 + (t0 >> 6)) * 4096) + (t0 & 63);
#pragma unroll
            for (int i = 0; i < 16; ++i) { v0[i] = acc[mi][0][i]; v1[i] = acc[mi][1][i]; }
            store_tr(tb, v0, v1, r, h);
        } else if (seg == 3 || seg == 7) {
#pragma unroll
            for (int i = 0; i < 16; ++i) { v0[i] = silu(acc[mi][0][i]); v1[i] = silu(acc[mi][1][i]); }
            stage_store(stg, v0, v1, (seg == 3 ? p.RG : p.DG) + (size_t)tok0 * 512 + cseg0, 512, lane);
        } else if (seg == 4 || seg == 5) {
            {
                const int pb = pos0 + 4 * h, f = r & 7;
                float cg = p.cosD[pb * 8 + f], sg = p.sinD[pb * 8 + f];
                const float c1 = p.cosD[8 + f], s1 = p.sinD[8 + f], c8 = p.cosD[64 + f], s8 = p.sinD[64 + f];
#pragma unroll
                for (int g = 0; g < 4; ++g) {
                    float c = cg, s = sg;
#pragma unroll
                    for (int b = 0; b < 4; ++b) {
                        const int i = 4 * g + b;
                        const float v = acc[mi][0][i], pr = __int_as_float(__builtin_amdgcn_update_dpp(0, __float_as_int(v), 0x128, 0xf, 0xf, false));
                        v0[i] = r < 8 ? v * c - pr * s : (r < 16 ? v * c + pr * s : v); v1[i] = acc[mi][1][i];
                        const float cn = c * c1 - s * s1, sn = s * c1 + c * s1; c = cn; s = sn;
                    }
                    const float cn = cg * c8 - sg * s8, sn = sg * c8 + cg * s8; cg = cn; sg = sn;
                }
            }
            if (seg == 4) {
#pragma unroll
                for (int i = 0; i < 16; ++i) { v0[i] *= QSCALE; v1[i] *= QSCALE; }
                stage_store(stg, v0, v1, p.DQ + (size_t)tok0 * 512 + cseg0, 512, lane);
            } else {
                float* ko = (samp ? p.out + O_KS + (size_t)(tok0 - TP) * 512 : p.out + O_KP + (size_t)tok0 * 512) + cseg0 + r;
                const int head4 = cseg0 >> 7, colh = cseg0 & 127;
                u16* kb = (samp ? p.SK + ((size_t)(bseq * 4 + head4) * 17 + 16) * 8192 : p.DKp + ((size_t)(bseq * 4 + head4) * 128 + (t0 >> 6)) * 8192) + (t0 & 63) * 128 + colh;
#pragma unroll
                for (int i = 0; i < 16; ++i) { const size_t ro = (size_t)crow(i, h) * 512; __builtin_nontemporal_store(v0[i], ko + ro); __builtin_nontemporal_store(v1[i], ko + ro + 32); }
                stage_store(stg, v0, v1, kb, 128, lane, false);
            }
        } else {
            float* vo = (samp ? p.out + O_VS + (size_t)(tok0 - TP) * 512 : p.out + O_VP + (size_t)tok0 * 512) + cseg0 + r;
            const int head4 = cseg0 >> 7, dv0 = cseg0 & 127;
            u16* tb = (samp ? p.SVt + ((size_t)(bseq * 4 + head4) * 17 + 16) * 8192 : p.DVtp + ((size_t)(bseq * 4 + head4) * 128 + (t0 >> 6)) * 8192) + dv0 * 64 + (t0 & 63);
#pragma unroll
            for (int i = 0; i < 16; ++i) { v0[i] = acc[mi][0][i]; v1[i] = acc[mi][1][i]; const size_t ro = (size_t)crow(i, h) * 512; __builtin_nontemporal_store(v0[i], vo + ro); __builtin_nontemporal_store(v1[i], vo + ro + 32); }
            store_tr(tb, v0, v1, r, h, false);
        }
    }
}

template <int MI> DI void gemm_core(const u16* __restrict__ Ag, const u16* __restrict__ Bg, u16* smem16, f32x16 (&acc)[MI][2], int tid) {
    constexpr int AST = 64 * MI * 40, STAGE = AST + 128 * 40;
    const int lane = tid & 63, wid = tid >> 6, r = lane & 31, h = lane >> 5, wm = wid >> 1, wn = wid & 1, lrow = tid >> 2, lch = tid & 3;
    const u16* ag = Ag + (size_t)lrow * 1024 + lch * 8; const u16* bg = Bg + (size_t)lrow * 1024 + lch * 8;
    const int wofs = lrow * 40 + lch * 8;
    const int afo = (32 * MI * wm + r) * 40 + 8 * h, bfo = AST + (64 * wn + r) * 40 + 8 * h;
#pragma unroll
    for (int a = 0; a < MI; ++a) { acc[a][0] = zero16(); acc[a][1] = zero16(); }
    u32x4 ra[MI], rb[2];
#pragma unroll
    for (int i = 0; i < MI; ++i) ra[i] = *(const u32x4*)(ag + (size_t)i * 64 * 1024);
#pragma unroll
    for (int i = 0; i < 2; ++i) rb[i] = *(const u32x4*)(bg + (size_t)i * 64 * 1024);
    __syncthreads();
#pragma unroll
    for (int i = 0; i < MI; ++i) *(u32x4*)(smem16 + wofs + i * 64 * 40) = ra[i];
#pragma unroll
    for (int i = 0; i < 2; ++i) *(u32x4*)(smem16 + AST + wofs + i * 64 * 40) = rb[i];
#pragma unroll
    for (int i = 0; i < MI; ++i) ra[i] = *(const u32x4*)(ag + (size_t)i * 64 * 1024 + 32);
#pragma unroll
    for (int i = 0; i < 2; ++i) rb[i] = *(const u32x4*)(bg + (size_t)i * 64 * 1024 + 32);
    __syncthreads();
    for (int kt = 0; kt < 32; ++kt) {
        const u16* cur = smem16 + (kt & 1) * STAGE;
        u16* nxt = smem16 + ((kt & 1) ^ 1) * STAGE;
        bf16x8 a0[MI], b0[2], a1[MI], b1[2];
#pragma unroll
        for (int mi = 0; mi < MI; ++mi) a0[mi] = *(const bf16x8*)(cur + afo + mi * 32 * 40);
#pragma unroll
        for (int ni = 0; ni < 2; ++ni) b0[ni] = *(const bf16x8*)(cur + bfo + ni * 32 * 40);
        __builtin_amdgcn_sched_barrier(0);
        if (kt < 31) {
#pragma unroll
            for (int i = 0; i < MI; ++i) *(u32x4*)(nxt + wofs + i * 64 * 40) = ra[i];
#pragma unroll
            for (int i = 0; i < 2; ++i) *(u32x4*)(nxt + AST + wofs + i * 64 * 40) = rb[i];
            if (kt < 30) {
#pragma unroll
                for (int i = 0; i < MI; ++i) ra[i] = *(const u32x4*)(ag + (size_t)i * 64 * 1024 + (kt + 2) * 32);
#pragma unroll
                for (int i = 0; i < 2; ++i) rb[i] = *(const u32x4*)(bg + (size_t)i * 64 * 1024 + (kt + 2) * 32);
            }
        }
#pragma unroll
        for (int mi = 0; mi < MI; ++mi) a1[mi] = *(const bf16x8*)(cur + afo + mi * 32 * 40 + 16);
#pragma unroll
        for (int ni = 0; ni < 2; ++ni) b1[ni] = *(const bf16x8*)(cur + bfo + ni * 32 * 40 + 16);
        __builtin_amdgcn_sched_barrier(0);
#pragma unroll
        for (int mi = 0; mi < MI; ++mi) { acc[mi][0] = MFMA32(a0[mi], b0[0], acc[mi][0]); acc[mi][1] = MFMA32(a0[mi], b0[1], acc[mi][1]); }
#pragma unroll
        for (int mi = 0; mi < MI; ++mi) { acc[mi][0] = MFMA32(a1[mi], b1[0], acc[mi][0]); acc[mi][1] = MFMA32(a1[mi], b1[1], acc[mi][1]); }
        __syncthreads();
    }
}

__device__ void p1_gemm(const Params& p, unsigned char* smem) {
    for (int tile_ = blockIdx.x; tile_ < 136 * 32 * REP1; tile_ += gridDim.x) {
        int tid = threadIdx.x; asm volatile("" : "+v"(tid));
        const int tile = tile_ % (136 * 32);
        int mt = tile >> 5, nt = tile & 31;
        if (tile < 4096 && (gridDim.x & 511) == 0) {
            const int rnd = tile >> 9, b = tile & 511, x = b & 7, idx = b >> 3;
            mt = rnd * 16 + 4 * (x >> 1) + (idx >> 4); nt = 16 * (x & 1) + (idx & 15);
        }
        f32x16 acc[4][2];
        gemm_core<4>(p.H + (size_t)mt * 256 * 1024, p.WtIn + (size_t)nt * 128 * 1024, (u16*)smem, acc, tid);
        __syncthreads();
        p1_epilogue<4>(p, acc, mt, nt, (tid >> 6) >> 1, (tid >> 6) & 1, tid & 63, (float*)smem + (tid >> 6) * (32 * 68));
    }
    {
        int tid = threadIdx.x; asm volatile("" : "+v"(tid));
        int* s_item = (int*)(smem + 73728);
        float* tile0 = (float*)smem; float* tile1 = tile0 + 64 * 65;
        for (;;) {
            __syncthreads();
            if (tid == 0) *s_item = (int)atomicAdd(p.ctr + 8 * 32, 1u);
            __syncthreads();
            const int j = __builtin_amdgcn_readfirstlane(*s_item);
            if (j >= 4096) break;
            if (j < 2048) {
                const TJob j0 = tjob(p, 1280 + 2 * j), j1 = tjob(p, 1280 + 2 * j + 1);
                f32x4 v0[4], v1[4];
                tr_load(j0, v0, tid); tr_load(j1, v1, tid);
                tr_put(v0, tile0, tid); tr_put(v1, tile1, tid);
                __syncthreads();
                tr_store(j0, tile0, tid); tr_store(j1, tile1, tid);
            } else {
                const size_t base = (size_t)(j - 2048) * 2048;
                f32x4 v[8];
#pragma unroll
                for (int q = 0; q < 8; ++q) v[q] = __builtin_nontemporal_load((const f32x4*)(p.cache_k + (base + tid + 256 * q) * 4));
#pragma unroll
                for (int q = 0; q < 8; ++q) {
                    const size_t i = base + tid + 256 * q, row = i >> 7; const int c4 = (int)(i & 127), sb = (int)(row >> 10), t = (int)(row & 1023);
                    u32x2 w; w.x = pk2(v[q].x, v[q].y); w.y = pk2(v[q].z, v[q].w);
                    *(u32x2*)(p.SK + ((size_t)(sb * 4 + (c4 >> 5)) * 17 + (t >> 6)) * 8192 + (t & 63) * 128 + (c4 & 31) * 4) = w;
                }
            }
        }
    }
}

constexpr int KV_STAGE = 2 * 128 * 72;
__device__ void attn_unit(const Params& p, unsigned char* smem, const u16* __restrict__ qptr, const u16* __restrict__ kptr, const u16* __restrict__ vtptr,
                          int ntiles, int tok0, int head) {
    u16* sKV = (u16*)smem;
    int tid = threadIdx.x; asm volatile("" : "+v"(tid)); const int lane = tid & 63, wid = tid >> 6, r = lane & 31, h = lane >> 5, c = wid & 1, rg = wid >> 1;
    bf16x8 qf[4];
#pragma unroll
    for (int ks = 0; ks < 4; ++ks) qf[ks] = *(const bf16x8*)(qptr + (size_t)(32 * rg + r) * 512 + c * 64 + 16 * ks + 8 * h);
    f32x16 O[4];
#pragma unroll
    for (int i = 0; i < 4; ++i) O[i] = zero16();
    float m = -1e30f, l = 0.f;
    const int kkey = tid >> 4, kcc = tid & 15;
    const int vdv = tid >> 3, vch = tid & 7;
    const u16* kg = kptr + tid * 8;
    const u16* vg = vtptr + tid * 8;
    const int klo = ((kcc >> 3) * 64 + kkey) * 72 + (kcc & 7) * 8;
    const int vlo = 128 * 72 + vdv * 72 + vch * 8;
    const int kfo = (c * 64 + r) * 72 + 8 * h;
    const int vfo = 128 * 72 + r * 72 + 8 * h;
    u32x4 rk[4], rv[4];
#pragma unroll
    for (int i = 0; i < 4; ++i) { rk[i] = *(const u32x4*)(kg + i * 2048); rv[i] = *(const u32x4*)(vg + i * 2048); }
    __syncthreads();
#pragma unroll
    for (int i = 0; i < 4; ++i) { *(u32x4*)(sKV + klo + i * 16 * 72) = rk[i]; *(u32x4*)(sKV + vlo + i * 32 * 72) = rv[i]; }
    if (ntiles > 1) {
#pragma unroll
        for (int i = 0; i < 4; ++i) { rk[i] = *(const u32x4*)(kg + 8192 + i * 2048); rv[i] = *(const u32x4*)(vg + 8192 + i * 2048); }
    }
    __syncthreads();
    for (int kt = 0; kt < ntiles; ++kt) {
        const u16* cur = sKV + (kt & 1) * KV_STAGE;
        u16* nxt = sKV + ((kt & 1) ^ 1) * KV_STAGE;
        bf16x8 kf[2][4];
#pragma unroll
        for (int ks = 0; ks < 4; ++ks) { kf[0][ks] = *(const bf16x8*)(cur + kfo + 16 * ks); kf[1][ks] = *(const bf16x8*)(cur + kfo + 32 * 72 + 16 * ks); }
        __builtin_amdgcn_sched_barrier(0);
        f32x16 S0 = zero16(), S1 = zero16();
#pragma unroll
        for (int ks = 0; ks < 4; ++ks) { S0 = MFMA32(kf[0][ks], qf[ks], S0); S1 = MFMA32(kf[1][ks], qf[ks], S1); __builtin_amdgcn_sched_barrier(0); }
        bf16x8 va[4][2];
#pragma unroll
        for (int d = 0; d < 4; ++d)
#pragma unroll
            for (int q = 0; q < 2; ++q) va[d][q] = *(const bf16x8*)(cur + vfo + d * 32 * 72 + 16 * q);
        if (kt + 1 < ntiles) {
#pragma unroll
            for (int i = 0; i < 4; ++i) { *(u32x4*)(nxt + klo + i * 16 * 72) = rk[i]; *(u32x4*)(nxt + vlo + i * 32 * 72) = rv[i]; }
            if (kt + 2 < ntiles) {
#pragma unroll
                for (int i = 0; i < 4; ++i) { rk[i] = *(const u32x4*)(kg + (size_t)(kt + 2) * 8192 + i * 2048); rv[i] = *(const u32x4*)(vg + (size_t)(kt + 2) * 8192 + i * 2048); }
            }
        }
        __builtin_amdgcn_sched_barrier(0);
        float mt = fmaxf(S0[0], S1[0]);
#pragma unroll
        for (int i = 1; i < 16; ++i) mt = fmaxf(mt, fmaxf(S0[i], S1[i]));
        mt = xhalf_max(mt);
        if (__any(mt > m)) {
            const float mn = fmaxf(m, mt), al = __builtin_amdgcn_exp2f(m - mn);
            m = mn; l *= al;
#pragma unroll
            for (int d = 0; d < 4; ++d)
#pragma unroll
                for (int i = 0; i < 16; ++i) O[d][i] *= al;
        }
        const f32x2 m2 = {m, m};
        f32x2 l2 = {0.f, 0.f};
        u32x4 pw[4];
#pragma unroll
        for (int j = 0; j < 8; ++j) {
            f32x2 x0 = {S0[2 * j], S0[2 * j + 1]};
            x0 = x0 - m2;
            f32x2 e0; e0.x = __builtin_amdgcn_exp2f(x0.x); e0.y = __builtin_amdgcn_exp2f(x0.y);
            l2 = l2 + e0;
            pw[j >> 2][j & 3] = pk2(e0.x, e0.y);
        }
        const bf16x8 p00 = __builtin_bit_cast(bf16x8, pw[0]), p01 = __builtin_bit_cast(bf16x8, pw[1]);
        bf16x8 vb[4][2];
#pragma unroll
        for (int d = 0; d < 4; ++d)
#pragma unroll
            for (int q = 0; q < 2; ++q) vb[d][q] = *(const bf16x8*)(cur + vfo + d * 32 * 72 + 32 + 16 * q);
#pragma unroll
        for (int j = 0; j < 8; ++j) {
            O[j & 3] = MFMA32(va[j & 3][j >> 2], (j >> 2) ? p01 : p00, O[j & 3]);
            f32x2 x1 = {S1[2 * j], S1[2 * j + 1]};
            x1 = x1 - m2;
            f32x2 e1; e1.x = __builtin_amdgcn_exp2f(x1.x); e1.y = __builtin_amdgcn_exp2f(x1.y);
            l2 = l2 + e1;
            pw[2 + (j >> 2)][j & 3] = pk2(e1.x, e1.y);
        }
        l += l2.x + l2.y;
        const bf16x8 p10 = __builtin_bit_cast(bf16x8, pw[2]), p11 = __builtin_bit_cast(bf16x8, pw[3]);
#pragma unroll
        for (int j = 0; j < 8; ++j) O[j & 3] = MFMA32(vb[j & 3][j >> 2], (j >> 2) ? p11 : p10, O[j & 3]);
        __syncthreads();
    }
    const float inv = 1.f / xhalf_sum(l);
    const float lam = p.misc[0];
    float* ex = (float*)smem + rg * 4096;
    if (c == 1) {
        const float sc = inv * lam;
#pragma unroll
        for (int d = 0; d < 4; ++d)
#pragma unroll
            for (int i = 0; i < 16; ++i) ex[(d * 16 + i) * 64 + lane] = O[d][i] * sc;
    }
    __syncthreads();
    if (c == 0) {
        float ss = 0.f;
#pragma unroll
        for (int d = 0; d < 4; ++d)
#pragma unroll
            for (int i = 0; i < 16; ++i) { const float v = O[d][i] * inv - ex[(d * 16 + i) * 64 + lane]; O[d][i] = v; ss += v * v; }
        ss += __shfl_xor(ss, 32);
        const float rstd = rsqrtf(ss * (1.f / 128.f) + EPS) * 0.8f;
        const size_t tok = (size_t)(tok0 + 32 * rg + r);
#pragma unroll
        for (int d = 0; d < 4; ++d)
#pragma unroll
            for (int g = 0; g < 4; ++g) {
                const int dv0 = 32 * d + 8 * g + 4 * h;
                const u32x2 gt = *(const u32x2*)(p.DG + tok * 512 + head * 128 + dv0);
                const f32x4 gn = *(const f32x4*)(p.diff_norm_g + dv0);
                u32x2 w;
                w.x = pk2(O[d][4 * g + 0] * rstd * gn.x * bf2f(gt.x & 0xffffu), O[d][4 * g + 1] * rstd * gn.y * bf2f(gt.x >> 16));
                w.y = pk2(O[d][4 * g + 2] * rstd * gn.z * bf2f(gt.y & 0xffffu), O[d][4 * g + 3] * rstd * gn.w * bf2f(gt.y >> 16));
                *(u32x2*)(p.MIX + tok * 1024 + 512 + head * 128 + dv0) = w;
            }
    }
}

__device__ void ret_scan_item(const Params& p, int seqi, int hd) {
    int tid = threadIdx.x; asm volatile("" : "+v"(tid)); const int lane = tid & 63, wid = tid >> 6, r = lane & 31, h = lane >> 5, dvb = wid >> 1, dkb = wid & 1;
    const bool samp = seqi >= 4; const int sb = seqi - 4;
    const size_t tbase = samp ? TR_S_OFF + (size_t)(sb * 8 + hd) * 4096 : ((size_t)(seqi * 8 + hd) * 128) * 4096;
    const u16* vt = p.RVt + tbase + (size_t)(32 * dvb + r) * 64 + 8 * h;
    const u16* kt = p.RKtd + tbase + (size_t)(32 * dkb + r) * 64 + 8 * h;
    const int nch = samp ? 1 : 128;
    u16* sprev = p.SPREV + (size_t)(samp ? 4096 + sb * 8 + hd : (seqi * 8 + hd) * 128) * 4096;
    float* so = samp ? p.out + O_SS + (size_t)(sb * 8 + hd) * 4096 : p.out + O_SP + (size_t)(seqi * 8 + hd) * 4096;
    const int dk = 32 * dkb + r;
    f32x16 S = zero16();
    if (samp) {
        const float* si = p.state_ret + (size_t)(sb * 8 + hd) * 4096 + (size_t)dk * 64 + 32 * dvb + 4 * h;
#pragma unroll
        for (int g = 0; g < 4; ++g) { const f32x4 v = *(const f32x4*)(si + 8 * g); S[4 * g] = v.x; S[4 * g + 1] = v.y; S[4 * g + 2] = v.z; S[4 * g + 3] = v.w; }
    }
    const float g64 = exp2f(log2_gamma(hd) * 64.f);
    bf16x8 an[4], bn[4];
#pragma unroll
    for (int ks = 0; ks < 4; ++ks) { an[ks] = *(const bf16x8*)(vt + 16 * ks); bn[ks] = *(const bf16x8*)(kt + 16 * ks); }
    for (int c = 0; c < nch; ++c) {
        bf16x8 a[4], b[4];
#pragma unroll
        for (int ks = 0; ks < 4; ++ks) { a[ks] = an[ks]; b[ks] = bn[ks]; }
        if (c + 1 < nch) {
#pragma unroll
            for (int ks = 0; ks < 4; ++ks) { an[ks] = *(const bf16x8*)(vt + (size_t)(c + 1) * 4096 + 16 * ks); bn[ks] = *(const bf16x8*)(kt + (size_t)(c + 1) * 4096 + 16 * ks); }
        }
#pragma unroll
        for (int i = 0; i < 16; ++i) sprev[(size_t)c * 4096 + (32 * dvb + crow(i, h)) * 64 + dk] = f2bf(S[i]);
        f32x16 KV = zero16();
#pragma unroll
        for (int ks = 0; ks < 4; ++ks) KV = MFMA32(a[ks], b[ks], KV);
#pragma unroll
        for (int i = 0; i < 16; ++i) S[i] = g64 * S[i] + KV[i];
    }
#pragma unroll
    for (int g = 0; g < 4; ++g) { f32x4 v = {S[4 * g], S[4 * g + 1], S[4 * g + 2], S[4 * g + 3]}; *(f32x4*)(so + (size_t)dk * 64 + 32 * dvb + 4 * h + 8 * g) = v; }
    asm volatile("s_waitcnt vmcnt(0)" ::: "memory");
    __syncthreads();
    if (tid == 0) {
        __builtin_amdgcn_fence(__ATOMIC_RELEASE, "agent");
        asm volatile("s_waitcnt vmcnt(0)" ::: "memory");
        __hip_atomic_fetch_add(p.done + seqi * 2 + (hd >> 2), 1u, __ATOMIC_RELAXED, __HIP_MEMORY_SCOPE_AGENT);
    }
}

__device__ void p3_tile(const Params& p, int tile, int hh) {
    int tid = threadIdx.x;
    asm volatile("" : "+v"(tid));
    const int lane = tid & 63, wid = tid >> 6, r = lane & 31, h = lane >> 5;
    int hf, tokc, unit0, ustride; size_t vtb, L, pos0;
    if (tile < 1024) { const int b = tile >> 8, c = (tile >> 1) & 127; hf = tile & 1; tokc = b * 8192 + c * 64; unit0 = (b * 8) * 128 + c; ustride = 128; vtb = ((size_t)(b * 8) * 128 + c) * 4096; L = 128 * 4096; pos0 = 0; }
    else { const int k = tile - 1024, sb = k >> 1; hf = k & 1; tokc = TP + sb * 64; unit0 = 4096 + sb * 8; ustride = 1; vtb = TR_S_OFF + (size_t)(sb * 8) * 4096; L = 4096; pos0 = 0; }
    const int tok0 = tokc + 32 * hf;
    const int qi = 32 * hf + r;
    {
        const int hd = 4 * hh + wid;
        const float lg = log2_gamma(hd);
        bf16x8 qf[4];
#pragma unroll
        for (int ks = 0; ks < 4; ++ks) qf[ks] = *(const bf16x8*)(p.RQ + (size_t)(tok0 + r) * 512 + hd * 64 + 16 * ks + 8 * h);
        __builtin_amdgcn_sched_barrier(0);
        f32x16 S0 = zero16(), S1 = zero16();
#pragma unroll
        for (int ks = 0; ks < 4; ++ks) S0 = MFMA32(*(const bf16x8*)(p.RK + (size_t)(tokc + r) * 512 + hd * 64 + 16 * ks + 8 * h), qf[ks], S0);
        if (hf) {
#pragma unroll
            for (int ks = 0; ks < 4; ++ks) S1 = MFMA32(*(const bf16x8*)(p.RK + (size_t)(tokc + 32 + r) * 512 + hd * 64 + 16 * ks + 8 * h), qf[ks], S1);
        }
#pragma unroll
        for (int i = 0; i < 16; ++i) {
            const int k0 = crow(i, h), k1 = 32 + k0;
            S0[i] = qi >= k0 ? S0[i] * __builtin_amdgcn_exp2f(lg * (float)(qi - k0)) : 0.f;
            S1[i] = qi >= k1 ? S1[i] * __builtin_amdgcn_exp2f(lg * (float)(qi - k1)) : 0.f;
        }
        const bf16x8 p00 = pack8<0>(S0), p01 = pack8<1>(S0), p10 = pack8<0>(S1), p11 = pack8<1>(S1);
        __builtin_amdgcn_sched_barrier(0);
        const float qd = __builtin_amdgcn_exp2f(lg * (float)(qi + 1));
        const u16* vt = p.RVt + vtb + (size_t)hd * L + pos0 + 8 * h;
        const u16* sp = p.SPREV + (size_t)(unit0 + hd * ustride) * 4096 + 8 * h;
        float ss = 0.f;
        f32x16 o[2];
#pragma unroll
        for (int d = 0; d < 2; ++d) {
            f32x16 in = zero16(), cr = zero16();
            const u16* vr = vt + (size_t)(32 * d + r) * 64;
            in = MFMA32(*(const bf16x8*)(vr), p00, in);
            in = MFMA32(*(const bf16x8*)(vr + 16), p01, in);
            if (hf) { in = MFMA32(*(const bf16x8*)(vr + 32), p10, in); in = MFMA32(*(const bf16x8*)(vr + 48), p11, in); }
#pragma unroll
            for (int ks = 0; ks < 4; ++ks) cr = MFMA32(*(const bf16x8*)(sp + (32 * d + r) * 64 + 16 * ks), qf[ks], cr);
#pragma unroll
            for (int i = 0; i < 16; ++i) { const float v = in[i] + cr[i] * qd; o[d][i] = v; ss += v * v; }
            __builtin_amdgcn_sched_barrier(0);
        }
        ss += __shfl_xor(ss, 32);
        const float rstd = rsqrtf(ss * (1.f / 64.f) + EPS);
#pragma unroll
        for (int d = 0; d < 2; ++d)
#pragma unroll
            for (int g = 0; g < 4; ++g) {
                const int dv0 = 32 * d + 8 * g + 4 * h;
                const u32x2 gt = *(const u32x2*)(p.RG + (size_t)(tok0 + r) * 512 + hd * 64 + dv0);
                const f32x4 gn = *(const f32x4*)(p.ret_norm_g + hd * 64 + dv0);
                u32x2 w;
                w.x = pk2(o[d][4 * g + 0] * rstd * gn.x * bf2f(gt.x & 0xffffu), o[d][4 * g + 1] * rstd * gn.y * bf2f(gt.x >> 16));
                w.y = pk2(o[d][4 * g + 2] * rstd * gn.z * bf2f(gt.y & 0xffffu), o[d][4 * g + 3] * rstd * gn.w * bf2f(gt.y >> 16));
                *(u32x2*)(p.MIX + (size_t)(tok0 + r) * 1024 + hd * 64 + dv0) = w;
            }
    }
}


constexpr int XQ_ITEMS = 4 + 32 + 256 + 16 + 256 + 16;
DI void wait_done(const Params& p, int idx, int tid) {
    if (tid == 0) {
        unsigned sp = 0;
        while (__hip_atomic_load(p.done + idx, __ATOMIC_RELAXED, __HIP_MEMORY_SCOPE_AGENT) < 4u) { __builtin_amdgcn_s_sleep(2); if (++sp > (1u << 22)) break; }
        __builtin_amdgcn_fence(__ATOMIC_ACQUIRE, "agent");
        asm volatile("s_waitcnt vmcnt(0)" ::: "memory");
    }
    __syncthreads();
}
__device__ void p2_mix(const Params& p, unsigned char* smem) {
    int* s_item = (int*)(smem + 73728);
    int tid = threadIdx.x; asm volatile("" : "+v"(tid));
    const int xcc = (int)(xb_xcc_id() & 7u);
    for (int q = 0; q < 8; ++q) {
        const int x = (xcc + q) & 7;
        while (true) {
            __syncthreads();
            if (tid == 0) *s_item = (int)atomicAdd(p.ctr + x * 32, 1u);
            __syncthreads();
            const int it = __builtin_amdgcn_readfirstlane(*s_item);
            if (it >= XQ_ITEMS) break;
            int kind, arg;
            if (it < 4) { kind = 0; arg = it; }
            else if (it < 36) { kind = 4; arg = it - 4; }
            else if (it < 228) { kind = 1; arg = it - 36; }
            else if (it < 244) { kind = 2; arg = it - 228; }
            else if (it < 564) { const int g = (it - 244) / 10, e = (it - 244) % 10; if (e < 2) { kind = 1; arg = 192 + 2 * g + e; } else { kind = 3; arg = 8 * g + (e - 2); } }
            else { kind = 3; arg = 256 + (it - 564); }
            if (kind == 0) { const int s = 4 * x + arg; ret_scan_item(p, s >> 3, s & 7); }
            else if (kind == 4) { const int k = 32 * x + arg; ret_scan_item(p, 4 + (k >> 3), k & 7); }
            else if (kind == 1) {
                const int k = arg, j = 127 - (k >> 1), bh = 2 * x + (k & 1), b = bh >> 2, hh = bh & 3;
                const int tok0 = b * 8192 + j * 64;
                attn_unit(p, smem, p.DQ + (size_t)tok0 * 512 + hh * 128, p.DKp + (size_t)(bh * 128) * 8192, p.DVtp + (size_t)(bh * 128) * 8192, j + 1, tok0, hh);
            } else if (kind == 2) {
                const int k = 16 * x + arg, sb = k >> 2, hh = k & 3;
                const int tok0 = TP + sb * 64;
                attn_unit(p, smem, p.DQ + (size_t)tok0 * 512 + hh * 128, p.SK + (size_t)(k * 17) * 8192, p.SVt + (size_t)(k * 17) * 8192, 17, tok0, hh);
            } else if (arg < 256) {
                const int b = x >> 1, hh = x & 1;
                wait_done(p, b * 2 + hh, tid);
                p3_tile(p, b * 256 + arg, hh);
            } else {
                const int k = arg - 256, sb = 4 * x + (k >> 2), hf = (k >> 1) & 1, hh = k & 1;
                wait_done(p, (4 + sb) * 2 + hh, tid);
                p3_tile(p, 1024 + sb * 2 + hf, hh);
            }
        }
    }
}

template <int MI> DI void p5_tile(const Params& p, unsigned char* smem, int row0, int nt, int tid) {
    f32x16 acc[MI][2];
    gemm_core<MI>(p.MIX + (size_t)row0 * 1024, p.WtOut + (size_t)nt * 128 * 1024, (u16*)smem, acc, tid);
    const int lane = tid & 63, wid = tid >> 6, r = lane & 31, h = lane >> 5, wm = wid >> 1, wn = wid & 1;
    float* red = (float*)smem;
    __syncthreads();
#pragma unroll
    for (int mi = 0; mi < MI; ++mi) {
        const int rl = wm * 32 * MI + mi * 32, tok0 = row0 + rl;
        const float* xb = (tok0 < TP ? p.x_p + (size_t)tok0 * D : p.x_s + (size_t)(tok0 - TP) * D) + nt * 128 + wn * 64 + r;
        float* yb = p.out + O_Y + (size_t)tok0 * D + nt * 128 + wn * 64 + r;
#pragma unroll
        for (int i = 0; i < 16; ++i) {
            const size_t ro = (size_t)crow(i, h) * D;
            const float v0 = acc[mi][0][i] + __builtin_nontemporal_load(xb + ro), v1 = acc[mi][1][i] + __builtin_nontemporal_load(xb + ro + 32);
            yb[ro] = v0; yb[ro + 32] = v1;
            float s = v0 * v0 + v1 * v1;
            s += __int_as_float(__builtin_amdgcn_update_dpp(0, __float_as_int(s), 0x121, 0xf, 0xf, false));
            s += __int_as_float(__builtin_amdgcn_update_dpp(0, __float_as_int(s), 0x122, 0xf, 0xf, false));
            s += __int_as_float(__builtin_amdgcn_update_dpp(0, __float_as_int(s), 0x124, 0xf, 0xf, false));
            s += __int_as_float(__builtin_amdgcn_update_dpp(0, __float_as_int(s), 0x128, 0xf, 0xf, false));
            if ((r & 15) == 0) red[(wn * 2 + (r >> 4)) * 64 * MI + rl + crow(i, h)] = s;
        }
    }
    __syncthreads();
    if (tid < 64 * MI) unsafeAtomicAdd(p.rowss + row0 + tid, (red[tid] + red[64 * MI + tid]) + (red[128 * MI + tid] + red[192 * MI + tid]));
}
__device__ void p5_gemm(const Params& p, unsigned char* smem) {
    for (int tile_ = blockIdx.x; tile_ < (1024 + 256) * REP5; tile_ += gridDim.x) {
        int tid = threadIdx.x; asm volatile("" : "+v"(tid));
        const int tile = tile_ % (1024 + 256);
        if (tile < 1024) p5_tile<4>(p, smem, (tile >> 3) * 256, tile & 7, tid);
        else { const int t = tile - 1024; p5_tile<1>(p, smem, TP + (t >> 3) * 64, t & 7, tid); }
    }
}

__device__ void p6_norm(const Params& p) {
    const int tid = threadIdx.x, lane = tid & 63, wid = tid >> 6;
    f32x4 g[4];
#pragma unroll
    for (int i = 0; i < 4; ++i) g[i] = *(const f32x4*)(p.final_g + (lane + 64 * i) * 4);
    for (int row = (blockIdx.x * 4 + wid) * 2; row < T; row += gridDim.x * 8) {
        f32x4 v[2][4];
#pragma unroll
        for (int q = 0; q < 2; ++q)
#pragma unroll
            for (int i = 0; i < 4; ++i) v[q][i] = __builtin_nontemporal_load((const f32x4*)(p.out + O_Y + (size_t)(row + q) * D + (lane + 64 * i) * 4));
#pragma unroll
        for (int q = 0; q < 2; ++q) {
            const float rs = rsqrtf(p.rowss[row + q] * (1.f / 1024.f) + EPS);
#pragma unroll
            for (int i = 0; i < 4; ++i) { f32x4 o = v[q][i] * g[i] * rs; __builtin_nontemporal_store(o, (f32x4*)(p.out + O_Y + (size_t)(row + q) * D + (lane + 64 * i) * 4)); }
        }
    }
}

#define SMEM_DECL __shared__ __attribute__((aligned(16))) unsigned char smem[LDS_BYTES]
#if MULTI_LAUNCH
__global__ void __launch_bounds__(NTHREADS, 2) k_p0(Params p) { SMEM_DECL; p0_prep(p, smem); }
__global__ void __launch_bounds__(NTHREADS, 2) k_p1(Params p) { SMEM_DECL; p1_gemm(p, smem); }
__global__ void __launch_bounds__(NTHREADS, 2) k_p2(Params p) { SMEM_DECL; p2_mix(p, smem); }
__global__ void __launch_bounds__(NTHREADS, 2) k_p5(Params p) { SMEM_DECL; p5_gemm(p, smem); }
__global__ void __launch_bounds__(NTHREADS, 2) k_p6(Params p) { p6_norm(p); }
#else
__global__ void __launch_bounds__(NTHREADS, 2) fwd_megakernel(Params p) {
    SMEM_DECL;
    __shared__ uint4 xb_words;
    cg::grid_group grid = cg::this_grid();
    if (p.never) grid.sync();
    if (threadIdx.x == 0) xb_words = make_uint4(0u, 0u, 0u, 0u);
    __syncthreads();
    const XcdBarrier xb = xcd_barrier_post(p.bar, (volatile LAS unsigned*)&xb_words);
#pragma nounroll
    for (int rep = 0; rep < REP0; ++rep) p0_prep(p, smem);
    xcd_barrier(xb);
    p1_gemm(p, smem);
    xcd_barrier(xb);
    p2_mix(p, smem);
    xcd_barrier(xb);
    p5_gemm(p, smem);
    xcd_barrier(xb);
    p6_norm(p);
}
#endif

extern "C" void kernel_launch(void* const* d_in, const int* in_sizes, int n_in, void* d_out, int out_size, void* d_ws, size_t ws_size, hipStream_t stream) {
    Params p{};
    p.x_p = (const float*)d_in[0]; p.x_s = (const float*)d_in[1]; p.cache_k = (const float*)d_in[2]; p.cache_v = (const float*)d_in[3]; p.state_ret = (const float*)d_in[4];
    p.norm_g = (const float*)d_in[5]; p.w_in = (const float*)d_in[6]; p.w_out = (const float*)d_in[7]; p.ret_norm_g = (const float*)d_in[8]; p.diff_norm_g = (const float*)d_in[9];
    p.lam_q1 = (const float*)d_in[10]; p.lam_k1 = (const float*)d_in[11]; p.lam_q2 = (const float*)d_in[12]; p.lam_k2 = (const float*)d_in[13]; p.final_g = (const float*)d_in[14];
    p.out = (float*)d_out;
    unsigned char* w = (unsigned char*)d_ws; size_t off = 0;
    auto take = [&](size_t bytes) { unsigned char* r = w + off; off += (bytes + 255) & ~(size_t)255; return r; };
    const size_t HALF = (size_t)T * 512 * 2;
    p.H = (u16*)take(2 * HALF);
    p.MIX = p.H; p.SPREV = (u16*)take(HALF);
    p.WtIn = (u16*)take((size_t)4096 * 1024 * 2); p.WtOut = (u16*)take((size_t)1024 * 1024 * 2);
    p.RQ = (u16*)take(HALF); p.RK = (u16*)take(HALF); p.RKtd = (u16*)take(HALF); p.RVt = (u16*)take(HALF); p.RG = (u16*)take(HALF); p.DQ = (u16*)take(HALF); p.DG = (u16*)take(HALF);
    p.cosR = (float*)take(8192 * 32 * 4); p.sinR = (float*)take(8192 * 32 * 4); p.cosD = (float*)take(8192 * 8 * 4); p.sinD = (float*)take(8192 * 8 * 4);
    p.misc = (float*)take(256); p.ctr = (unsigned*)take(2048); p.done = (unsigned*)take(512); p.rowss = (float*)take((size_t)T * 4); p.bar = (unsigned*)take(XCD_BAR_WORDS * 4);
    unsigned char* yo = (unsigned char*)d_out; size_t yoff = 0;
    auto takey = [&](size_t bytes) { unsigned char* r = yo + yoff; yoff += (bytes + 255) & ~(size_t)255; return r; };
    p.DKp = (u16*)takey((size_t)TP * 512 * 2); p.SK = (u16*)takey((size_t)32 * SKL * 512 * 2); p.DVtp = (u16*)takey((size_t)2048 * 8192 * 2); p.SVt = (u16*)takey((size_t)16384 * SKL * 2);
    if (off > ws_size || yoff > (size_t)35651584 * 4) { fprintf(stderr, "workspace too small: need %zu have %zu\n", off, ws_size); return; }
#if MULTI_LAUNCH
    static int gb = 0;
    if (!gb) { int dev = 0, cus = 0; hipGetDevice(&dev); hipDeviceGetAttribute(&cus, hipDeviceAttributeMultiprocessorCount, dev); gb = cus * 2; }
    k_p0<<<gb, NTHREADS, 0, stream>>>(p); k_p1<<<gb, NTHREADS, 0, stream>>>(p); k_p2<<<gb, NTHREADS, 0, stream>>>(p); k_p5<<<gb, NTHREADS, 0, stream>>>(p); k_p6<<<gb, NTHREADS, 0, stream>>>(p);
#else
    static int grid_blocks = 0;
    if (!grid_blocks) {
        int dev = 0, cus = 0, per_cu = 0;
        hipGetDevice(&dev); hipDeviceGetAttribute(&cus, hipDeviceAttributeMultiprocessorCount, dev);
        hipOccupancyMaxActiveBlocksPerMultiprocessor(&per_cu, fwd_megakernel, NTHREADS, 0);
        if (per_cu > 2) per_cu = 2;
        if (per_cu < 1) per_cu = 1;
        grid_blocks = cus * per_cu;
    }
    hipMemsetAsync(p.bar, 0, XCD_BAR_WORDS * 4, stream);
    void* args[] = {&p};
    hipError_t e = hipLaunchCooperativeKernel((void*)fwd_megakernel, dim3(grid_blocks), dim3(NTHREADS), args, 0, stream);
    if (e != hipSuccess) fprintf(stderr, "cooperative launch failed: %s (grid %d)\n", hipGetErrorString(e), grid_blocks);
#endif
}
```
